# Optimizing an MI355X kernel written in HIP

```python
import math
import jax, jax.numpy as jnp
from jax import lax
import numpy as np

D_MODEL = 1024
BATCH = 32
SEQ = 256
DEPTH = 2
DEC_BATCH = 2
DEC_SEQ = 2048
PAST_LEN = 512

GRID_W = 64
Q_BLOCK = 128
ROPE_THETA = 10000.0
EPS = 1e-6

MLA_HEADS = 8
MLA_NOPE = 64
MLA_ROPE = 32
MLA_V = 64
MLA_Q_LORA = 256
MLA_KV_LORA = 128
MLA_WIDTH = MLA_HEADS * MLA_V
MLA_SCALE = (MLA_NOPE + MLA_ROPE) ** -0.5
DIFF_HEADS = 4
DIFF_HEAD_DIM = 64
DIFF_V = 2 * DIFF_HEAD_DIM
DIFF_WIDTH = DIFF_HEADS * DIFF_V
DIFF_SCALE = DIFF_HEAD_DIM ** -0.5
GQA_HEADS = 8
GQA_KV_HEADS = 2
GQA_HEAD_DIM = 64
GQA_GROUP = GQA_HEADS // GQA_KV_HEADS
GQA_WIDTH = GQA_HEADS * GQA_HEAD_DIM
GQA_SCALE = GQA_HEAD_DIM ** -0.5
SSM_WIDTH = 512
SSM_GROUP = 16
SSM_GROUPS = SSM_WIDTH // SSM_GROUP
SSM_STATE = 64
SSM_DT_MIN = 1e-3
SSM_DT_MAX = 1e-1

N_BRANCH = 4
BRANCH_WIDTH = 512
IN_SPLITS = (MLA_Q_LORA, MLA_KV_LORA, MLA_ROPE,
             DIFF_HEADS * 2 * DIFF_HEAD_DIM, DIFF_HEADS * 2 * DIFF_HEAD_DIM, DIFF_HEADS * DIFF_V,
             GQA_HEADS * GQA_HEAD_DIM, GQA_KV_HEADS * GQA_HEAD_DIM, GQA_KV_HEADS * GQA_HEAD_DIM,
             SSM_WIDTH,
             N_BRANCH * BRANCH_WIDTH,
             N_BRANCH * D_MODEL)
D_IN = sum(IN_SPLITS)

kernel_name = 'hybrid_prefix_dit_mla_diff_gqa_s5'


def _rms_norm(x, g):
    xf = x.astype(jnp.float32)
    y = xf * lax.rsqrt(jnp.mean(xf * xf, axis=-1, keepdims=True) + EPS)
    return (y * g.astype(jnp.float32)).astype(x.dtype)


def _modulate(x, g, shift, scale):
    return _rms_norm(x, g) * (1.0 + scale) + shift


def _rope_tables(n_tok, rot_dim):
    rows = n_tok // GRID_W
    row = jnp.repeat(jnp.arange(rows, dtype=jnp.float32), GRID_W)
    col = jnp.tile(jnp.arange(GRID_W, dtype=jnp.float32), rows)
    quarter = rot_dim // 4
    inv = ROPE_THETA ** (-jnp.arange(quarter, dtype=jnp.float32) / quarter)
    ang = jnp.concatenate([row[:, None] * inv, col[:, None] * inv], axis=-1)
    return jnp.cos(ang), jnp.sin(ang)


def _apply_rope(x, cos, sin):
    half = x.shape[-1] // 2
    xf = x.astype(jnp.float32)
    x1, x2 = xf[..., :half], xf[..., half:]
    c, s = cos[:, None, :], sin[:, None, :]
    return jnp.concatenate([x1 * c - x2 * s, x1 * s + x2 * c], axis=-1).astype(x.dtype)


def _sweep_query_blocks(fn, qs):
    b, t = qs[0].shape[0], qs[0].shape[1]
    nb = t // Q_BLOCK
    blocked = tuple(jnp.moveaxis(q.reshape((b, nb, Q_BLOCK) + q.shape[2:]), 1, 0) for q in qs)
    out = lax.map(lambda a: fn(*a), blocked)
    out = jnp.moveaxis(out, 0, 1)
    return out.reshape((b, t) + out.shape[3:])


def _softmax_attn(q, k, v, scale):
    s = jnp.einsum('bqhgd,bshd->bhgqs', q, k).astype(jnp.float32) * scale
    p = jax.nn.softmax(s, axis=-1)
    return jnp.einsum('bhgqs,bshe->bqhge', p.astype(v.dtype), v)


def _lin_combine(left, right):
    a1, b1 = left
    a2, b2 = right
    return a2 * a1, a2 * b1 + b2


def _ssm_direction(u, s0, a_re, a_im, log_dt, b_re, b_im, c_re, c_im):
    f32 = jnp.float32
    lam = lax.complex(a_re.astype(f32), a_im.astype(f32))
    dt = jnp.exp(log_dt.astype(f32))[:, None]
    abar = jnp.exp(lam * dt)
    bbar = ((abar - 1.0) / lam)[..., None] * lax.complex(b_re.astype(f32), b_im.astype(f32))
    cmat = lax.complex(c_re.astype(f32), c_im.astype(f32))
    bu = jnp.einsum('btgn,gpn->btgp', u.astype(jnp.complex64), bbar)
    if s0 is not None:
        bu = bu.at[:, 0].add(abar * s0)
    a = jnp.broadcast_to(abar, bu.shape)
    _, hs = lax.associative_scan(_lin_combine, (a, bu), axis=1)
    y = jnp.real(jnp.einsum('btgp,gnp->btgn', hs, cmat))
    return y, hs[:, -1]


def _mixer(h, p, lam_init, rope, ctx):
    b, t, _ = h.shape
    points, acc = [], 0
    for width in IN_SPLITS[:-1]:
        acc += width
        points.append(acc)
    (q_a, kv_a, k_pe, dq, dk, dv, gq, gk, gv, u, gate_in, merge_in) = jnp.split(h @ p['w_in'], points, axis=-1)
    latent = ctx is not None

    q = (_rms_norm(q_a, p['mla_q_norm']) @ p['w_mla_q_b']).reshape(b, t, MLA_HEADS, MLA_NOPE + MLA_ROPE)
    q_nope, q_pe = q[..., :MLA_NOPE], q[..., MLA_NOPE:]
    c_kv = _rms_norm(kv_a, p['mla_kv_norm'])
    k_pe = k_pe[:, :, None, :]
    if latent:
        q_pe = _apply_rope(q_pe, *rope['mla'])
        ckv_all = jnp.concatenate([ctx['mla_ckv'], c_kv], axis=1)
        kpe_all = jnp.concatenate([ctx['mla_krope'][:, :, None, :], _apply_rope(k_pe, *rope['mla'])], axis=1)
    else:
        ckv_all, kpe_all = c_kv, k_pe
    s_len = ckv_all.shape[1]
    kv = (ckv_all @ p['w_mla_kv_b']).reshape(b, s_len, MLA_HEADS, MLA_NOPE + MLA_V)
    k_a = jnp.concatenate([kv[..., :MLA_NOPE], jnp.broadcast_to(kpe_all, (b, s_len, MLA_HEADS, MLA_ROPE))], axis=-1)
    v_a = kv[..., MLA_NOPE:]
    q_full = jnp.concatenate([q_nope, q_pe], axis=-1)[:, :, :, None, :]
    o_a = _sweep_query_blocks(lambda qb: _softmax_attn(qb, k_a, v_a, MLA_SCALE), (q_full,)).reshape(b, t, MLA_WIDTH)

    dq = dq.reshape(b, t, DIFF_HEADS * 2, DIFF_HEAD_DIM)
    dk = dk.reshape(b, t, DIFF_HEADS * 2, DIFF_HEAD_DIM)
    dv = dv.reshape(b, t, DIFF_HEADS, DIFF_V)
    if latent:
        dq = _apply_rope(dq, *rope['diff'])
        dk_all = jnp.concatenate([ctx['diff_k'], _apply_rope(dk, *rope['diff']).reshape(b, t, DIFF_HEADS, 2, DIFF_HEAD_DIM)], axis=1)
        dv_all = jnp.concatenate([ctx['diff_v'], dv], axis=1)
    else:
        dk_all, dv_all = dk.reshape(b, t, DIFF_HEADS, 2, DIFF_HEAD_DIM), dv
    dq = dq.reshape(b, t, DIFF_HEADS, 2, DIFF_HEAD_DIM)
    f32 = jnp.float32
    lam = (jnp.exp(jnp.sum(p['diff_lq1'].astype(f32) * p['diff_lk1'].astype(f32)))
           - jnp.exp(jnp.sum(p['diff_lq2'].astype(f32) * p['diff_lk2'].astype(f32))) + lam_init)

    def diff_block(qb):
        s = jnp.einsum('bqhmd,bshmd->bhmqs', qb, dk_all).astype(f32) * DIFF_SCALE
        pr = jax.nn.softmax(s, axis=-1)
        w = pr[:, :, 0] - lam * pr[:, :, 1]
        return jnp.einsum('bhqs,bshe->bqhe', w.astype(dv_all.dtype), dv_all)

    o_b = _sweep_query_blocks(diff_block, (dq,))
    o_b = (_rms_norm(o_b, p['diff_subln']) * (1.0 - lam_init)).reshape(b, t, DIFF_WIDTH)

    gq = _rms_norm(gq.reshape(b, t, GQA_HEADS, GQA_HEAD_DIM), p['gqa_q_norm'])
    gk = _rms_norm(gk.reshape(b, t, GQA_KV_HEADS, GQA_HEAD_DIM), p['gqa_k_norm'])
    gv = gv.reshape(b, t, GQA_KV_HEADS, GQA_HEAD_DIM)
    if latent:
        gq = _apply_rope(gq, *rope['gqa'])
        gk_all = jnp.concatenate([ctx['gqa_k'], _apply_rope(gk, *rope['gqa'])], axis=1)
        gv_all = jnp.concatenate([ctx['gqa_v'], gv], axis=1)
    else:
        gk_all, gv_all = gk, gv
    gq5 = gq.reshape(b, t, GQA_KV_HEADS, GQA_GROUP, GQA_HEAD_DIM)
    o_c = _sweep_query_blocks(lambda qb: _softmax_attn(qb, gk_all, gv_all, GQA_SCALE), (gq5,)).reshape(b, t, GQA_WIDTH)

    uf = u.astype(f32)
    ug = uf.reshape(b, t, SSM_GROUPS, SSM_GROUP)
    if latent:
        st = ctx['ssm'].astype(f32)
        s0_f = lax.complex(st[:, 0, ..., 0], st[:, 0, ..., 1])
        s0_b = lax.complex(st[:, 1, ..., 0], st[:, 1, ..., 1])
    else:
        s0_f = s0_b = None
    y_f, hf_last = _ssm_direction(ug, s0_f, p['ssm_a_re'][0], p['ssm_a_im'][0], p['ssm_log_dt'][0],
                                  p['ssm_b_re'][0], p['ssm_b_im'][0], p['ssm_c_re'][0], p['ssm_c_im'][0])
    y_b, hb_last = _ssm_direction(jnp.flip(ug, axis=1), s0_b, p['ssm_a_re'][1], p['ssm_a_im'][1], p['ssm_log_dt'][1],
                                  p['ssm_b_re'][1], p['ssm_b_im'][1], p['ssm_c_re'][1], p['ssm_c_im'][1])
    y = (y_f + jnp.flip(y_b, axis=1)).reshape(b, t, SSM_WIDTH) + p['ssm_d'].astype(f32) * uf
    y = jax.nn.gelu(y).astype(h.dtype)
    o_d = y * jax.nn.sigmoid(y @ p['ssm_glu_w'] + p['ssm_glu_b'])

    br = jnp.stack([o_a, o_b, o_c, o_d], axis=2) * jax.nn.silu(gate_in.reshape(b, t, N_BRANCH, BRANCH_WIDTH))
    br = jnp.einsum('btnw,nwd->btnd', br, p['w_branch_out'])
    merged = jnp.sum(jax.nn.sigmoid(merge_in.reshape(b, t, N_BRANCH, D_MODEL)) * br, axis=2)
    out = merged @ p['w_out']
    if latent:
        return out, None
    ssm_state = jnp.stack([hf_last, hb_last], axis=1)
    side = (c_kv, k_pe[:, :, 0, :], dk_all, dv_all, gk_all, gv_all,
            jnp.stack([jnp.real(ssm_state), jnp.imag(ssm_state)], axis=-1))
    return out, side


def setup_inputs(seed: int = 0) -> dict:
    key = jax.random.key(seed)
    ks = iter(jax.random.split(key, 64))
    f32 = jnp.float32

    def nrm(shape, s=1.0):
        return jax.random.normal(next(ks), shape, f32) * s

    hw = (DEPTH, 2, SSM_GROUPS, SSM_STATE)
    return {
        'x_prompt': nrm((BATCH, SEQ, D_MODEL)),
        'x_sample': nrm((DEC_BATCH, DEC_SEQ, D_MODEL)),
        'cache_mla_ckv': nrm((DEC_BATCH, DEPTH, PAST_LEN, MLA_KV_LORA)),
        'cache_mla_krope': nrm((DEC_BATCH, DEPTH, PAST_LEN, MLA_ROPE)),
        'cache_diff_k': nrm((DEC_BATCH, DEPTH, PAST_LEN, DIFF_HEADS, 2, DIFF_HEAD_DIM)),
        'cache_diff_v': nrm((DEC_BATCH, DEPTH, PAST_LEN, DIFF_HEADS, DIFF_V)),
        'cache_gqa_k': nrm((DEC_BATCH, DEPTH, PAST_LEN, GQA_KV_HEADS, GQA_HEAD_DIM)),
        'cache_gqa_v': nrm((DEC_BATCH, DEPTH, PAST_LEN, GQA_KV_HEADS, GQA_HEAD_DIM)),
        'state_ssm': nrm((DEC_BATCH, DEPTH, 2, SSM_GROUPS, SSM_STATE, 2), 0.5),
        'c': nrm((DEC_BATCH, D_MODEL)),
        'c_ctx': nrm((D_MODEL,)),
        'norm_g': 1.0 + nrm((DEPTH, D_MODEL), 0.01),
        'w_mod': nrm((DEPTH, D_MODEL, 3 * D_MODEL), D_MODEL ** -0.5),
        'b_mod': nrm((DEPTH, 3 * D_MODEL), 0.01),
        'w_in': nrm((DEPTH, D_MODEL, D_IN), D_MODEL ** -0.5),
        'mla_q_norm': 1.0 + nrm((DEPTH, MLA_Q_LORA), 0.01),
        'w_mla_q_b': nrm((DEPTH, MLA_Q_LORA, MLA_HEADS * (MLA_NOPE + MLA_ROPE)), MLA_Q_LORA ** -0.5),
        'mla_kv_norm': 1.0 + nrm((DEPTH, MLA_KV_LORA), 0.01),
        'w_mla_kv_b': nrm((DEPTH, MLA_KV_LORA, MLA_HEADS * (MLA_NOPE + MLA_V)), MLA_KV_LORA ** -0.5),
        'diff_lq1': nrm((DEPTH, DIFF_HEAD_DIM), 0.1),
        'diff_lk1': nrm((DEPTH, DIFF_HEAD_DIM), 0.1),
        'diff_lq2': nrm((DEPTH, DIFF_HEAD_DIM), 0.1),
        'diff_lk2': nrm((DEPTH, DIFF_HEAD_DIM), 0.1),
        'diff_subln': 1.0 + nrm((DEPTH, DIFF_V), 0.01),
        'gqa_q_norm': 1.0 + nrm((DEPTH, GQA_HEAD_DIM), 0.01),
        'gqa_k_norm': 1.0 + nrm((DEPTH, GQA_HEAD_DIM), 0.01),
        'ssm_a_re': -0.5 + nrm(hw, 0.01),
        'ssm_a_im': jnp.broadcast_to(math.pi * jnp.arange(SSM_STATE, dtype=f32), hw) + nrm(hw, 0.01),
        'ssm_log_dt': jax.random.uniform(next(ks), (DEPTH, 2, SSM_GROUPS), f32,
                                         minval=math.log(SSM_DT_MIN), maxval=math.log(SSM_DT_MAX)),
        'ssm_b_re': nrm((DEPTH, 2, SSM_GROUPS, SSM_STATE, SSM_GROUP), (2 * SSM_GROUP) ** -0.5),
        'ssm_b_im': nrm((DEPTH, 2, SSM_GROUPS, SSM_STATE, SSM_GROUP), (2 * SSM_GROUP) ** -0.5),
        'ssm_c_re': nrm((DEPTH, 2, SSM_GROUPS, SSM_GROUP, SSM_STATE), (2 * SSM_STATE) ** -0.5),
        'ssm_c_im': nrm((DEPTH, 2, SSM_GROUPS, SSM_GROUP, SSM_STATE), (2 * SSM_STATE) ** -0.5),
        'ssm_d': 1.0 + nrm((DEPTH, SSM_WIDTH), 0.1),
        'ssm_glu_w': nrm((DEPTH, SSM_WIDTH, SSM_WIDTH), SSM_WIDTH ** -0.5),
        'ssm_glu_b': nrm((DEPTH, SSM_WIDTH), 0.01),
        'w_branch_out': nrm((DEPTH, N_BRANCH, BRANCH_WIDTH, D_MODEL), BRANCH_WIDTH ** -0.5),
        'w_out': nrm((DEPTH, D_MODEL, D_MODEL), D_MODEL ** -0.5),
        'final_norm': 1.0 + nrm((D_MODEL,), 0.01),
    }


def reference(x_prompt, x_sample, cache_mla_ckv, cache_mla_krope, cache_diff_k, cache_diff_v,
              cache_gqa_k, cache_gqa_v, state_ssm, c, c_ctx, norm_g, w_mod, b_mod, w_in,
              mla_q_norm, w_mla_q_b, mla_kv_norm, w_mla_kv_b, diff_lq1, diff_lk1, diff_lq2, diff_lk2,
              diff_subln, gqa_q_norm, gqa_k_norm, ssm_a_re, ssm_a_im, ssm_log_dt, ssm_b_re, ssm_b_im,
              ssm_c_re, ssm_c_im, ssm_d, ssm_glu_w, ssm_glu_b, w_branch_out, w_out, final_norm):
    n_lat = x_sample.shape[1]
    rope = {'mla': _rope_tables(n_lat, MLA_ROPE),
            'diff': _rope_tables(n_lat, DIFF_HEAD_DIM),
            'gqa': _rope_tables(n_lat, GQA_HEAD_DIM)}
    xp, xs = x_prompt, x_sample
    sides = []
    for l in range(DEPTH):
        p = dict(w_in=w_in[l], mla_q_norm=mla_q_norm[l], w_mla_q_b=w_mla_q_b[l], mla_kv_norm=mla_kv_norm[l],
                 w_mla_kv_b=w_mla_kv_b[l], diff_lq1=diff_lq1[l], diff_lk1=diff_lk1[l], diff_lq2=diff_lq2[l],
                 diff_lk2=diff_lk2[l], diff_subln=diff_subln[l], gqa_q_norm=gqa_q_norm[l],
                 gqa_k_norm=gqa_k_norm[l], ssm_a_re=ssm_a_re[l], ssm_a_im=ssm_a_im[l],
                 ssm_log_dt=ssm_log_dt[l], ssm_b_re=ssm_b_re[l], ssm_b_im=ssm_b_im[l],
                 ssm_c_re=ssm_c_re[l], ssm_c_im=ssm_c_im[l], ssm_d=ssm_d[l], ssm_glu_w=ssm_glu_w[l],
                 ssm_glu_b=ssm_glu_b[l], w_branch_out=w_branch_out[l], w_out=w_out[l])
        lam_init = 0.8 - 0.6 * math.exp(-0.3 * l)
        sh_c, sc_c, ga_c = jnp.split(jax.nn.silu(c_ctx) @ w_mod[l] + b_mod[l], 3, axis=-1)
        out_p, side = _mixer(_modulate(xp, norm_g[l], sh_c, sc_c), p, lam_init, None, None)
        xp = xp + ga_c * out_p
        sides.append(side)
        sh_s, sc_s, ga_s = jnp.split((jax.nn.silu(c) @ w_mod[l] + b_mod[l])[:, None, :], 3, axis=-1)
        ctx = {'mla_ckv': cache_mla_ckv[:, l], 'mla_krope': cache_mla_krope[:, l],
               'diff_k': cache_diff_k[:, l], 'diff_v': cache_diff_v[:, l],
               'gqa_k': cache_gqa_k[:, l], 'gqa_v': cache_gqa_v[:, l], 'ssm': state_ssm[:, l]}
        out_s, _ = _mixer(_modulate(xs, norm_g[l], sh_s, sc_s), p, lam_init, rope, ctx)
        xs = xs + ga_s * out_s
    y_prompt = _rms_norm(xp, final_norm)
    y_sample = _rms_norm(xs, final_norm)
    new_mla_ckv = jnp.stack([s[0] for s in sides], axis=1)
    new_mla_krope = jnp.stack([s[1] for s in sides], axis=1)
    new_diff_k = jnp.stack([s[2] for s in sides], axis=1)
    new_diff_v = jnp.stack([s[3] for s in sides], axis=1)
    new_gqa_k = jnp.stack([s[4] for s in sides], axis=1)
    new_gqa_v = jnp.stack([s[5] for s in sides], axis=1)
    new_state_ssm = jnp.stack([s[6] for s in sides], axis=1)
    return (y_prompt, y_sample, new_mla_ckv, new_mla_krope, new_diff_k, new_diff_v, new_gqa_k, new_gqa_v, new_state_ssm)
```

```cpp
#include <hip/hip_runtime.h>
#include <hip/hip_cooperative_groups.h>
#include <cstdint>
#include <cstdio>
namespace cg = cooperative_groups;

#ifndef ONE_LAUNCH
#define ONE_LAUNCH 0
#endif

#define LAS __attribute__((address_space(3)))
typedef _Float16 half_t;
typedef _Float16 half8 __attribute__((ext_vector_type(8)));
typedef _Float16 half4 __attribute__((ext_vector_type(4)));
typedef _Float16 half2v __attribute__((ext_vector_type(2)));
typedef float f32x4 __attribute__((ext_vector_type(4)));
typedef float f32x16 __attribute__((ext_vector_type(16)));
typedef short v4i16_t __attribute__((ext_vector_type(4)));
typedef unsigned u32x2 __attribute__((ext_vector_type(2)));

constexpr int DM = 1024, NPT = 8192, NLT = 4096, NTOK = NPT + NLT, NKEY = 8192 + 2 * 2560;
constexpr int LSEQ = 2048, PSEQ = 256, LKEYS = 2560, PAST = 512;
constexpr int D_IN = 9376, NW1 = 9472;
constexpr int P1W = 3328;
constexpr int SGW = 2048;
constexpr float EPS = 1e-6f;
constexpr float LOG2E = 1.4426950408889634f;
constexpr int C_QA = 0, C_KVA = 256, C_KPE = 384, C_DQ = 512, C_DK = 1024, C_DV = 1536, C_GQ = 2048, C_GK = 2560, C_GV = 2688, C_U = 2816;
constexpr size_t O_Y = 0, O_CKV = 12582912, O_KROPE = 14680064, O_DK = 15204352, O_DV = 23592960, O_GK = 31981568, O_GV = 34078720, O_ST = 36175872;

constexpr size_t al256(size_t x) { return (x + 255) & ~(size_t)255; }
constexpr size_t WS_CTRL = 0;
constexpr size_t WS_MOD = 65536;
constexpr size_t WS_LAM = WS_MOD + al256(2 * 3 * 3072 * 4);
constexpr size_t WS_ROPE64 = WS_LAM + 256;
constexpr size_t WS_ROPE32 = WS_ROPE64 + 2048 * 32 * 2 * 4;
constexpr size_t WS_ABAR = WS_ROPE32 + 2048 * 16 * 2 * 4;
constexpr size_t WS_BM = WS_ABAR + 128 * 64 * 2 * 4;
constexpr size_t WS_BSC = WS_BM + 128 * 128 * 16 * 2;
constexpr size_t WS_CM = WS_BSC + 512;
constexpr size_t WS_WIN = WS_CM + 128 * 16 * 128 * 2;
constexpr size_t WS_WQB = WS_WIN + (size_t)2 * NW1 * 1024 * 2;
constexpr size_t WS_WKVB = WS_WQB + (size_t)2 * 768 * 256 * 2;
constexpr size_t WS_WGLU = WS_WKVB + (size_t)2 * 1024 * 256 * 2;
constexpr size_t WS_WBR = WS_WGLU + (size_t)2 * 512 * 512 * 2;
constexpr size_t WS_WOUT = WS_WBR + (size_t)2 * 4 * 1024 * 512 * 2;
constexpr size_t WS_H = WS_WOUT + (size_t)2 * 1024 * 1024 * 2;
constexpr size_t WS_P1 = WS_H + (size_t)NTOK * 1024 * 2;
constexpr size_t WS_SG = WS_P1 + (size_t)NKEY * P1W * 2;
constexpr size_t WS_QA = WS_SG + (size_t)NTOK * SGW * 2;
constexpr size_t WS_KVA = WS_QA + (size_t)NTOK * 768 * 2;
constexpr size_t WS_Y = WS_KVA + (size_t)NKEY * 1024 * 2;
constexpr size_t WS_END = WS_Y + (size_t)NTOK * 512 * 2;

constexpr int LDS_BYTES = 122880;
constexpr int NTHR = 512;

struct Params {
  const float* in[39];
  float* out;
  char* ws;
};
enum { I_XP = 0, I_XS, I_CCKV, I_CKROPE, I_CDK, I_CDV, I_CGK, I_CGV, I_STATE, I_C, I_CCTX, I_NORMG, I_WMOD, I_BMOD, I_WIN, I_QNORM, I_WQB, I_KVNORM, I_WKVB,
       I_LQ1, I_LK1, I_LQ2, I_LK2, I_SUBLN, I_GQN, I_GKN, I_ARE, I_AIM, I_LOGDT, I_BRE, I_BIM, I_CRE, I_CIM, I_SSMD, I_GLUW, I_GLUB, I_WBR, I_WOUT, I_FNORM };

__device__ __forceinline__ float wave_sum(float v) {
#pragma unroll
  for (int o = 1; o < 64; o <<= 1) v += __shfl_xor(v, o);
  return v;
}
__device__ __forceinline__ float sigmoidf_(float x) { return 1.0f / (1.0f + __expf(-x)); }
__device__ __forceinline__ float siluf_(float x) { return x / (1.0f + __expf(-x)); }
__device__ __forceinline__ float gelu_tanh(float x) {
  const float z = 0.7978845608028654f * (x + 0.044715f * x * x * x);
  const float e = __expf(2.0f * z);
  const float th = 1.0f - 2.0f / (e + 1.0f);
  return 0.5f * x * (1.0f + th);
}
__device__ __forceinline__ half4 to_half4(f32x4 v) { half4 h; h[0] = (half_t)v[0]; h[1] = (half_t)v[1]; h[2] = (half_t)v[2]; h[3] = (half_t)v[3]; return h; }
__device__ __forceinline__ f32x4 to_f32x4(half4 h) { f32x4 v; v[0] = (float)h[0]; v[1] = (float)h[1]; v[2] = (float)h[2]; v[3] = (float)h[3]; return v; }
__device__ __forceinline__ int tile_keyrow(int rt) {
  if (rt < 32) return rt * 256;
  const int j = rt - 32; return 8192 + (j >> 3) * LKEYS + PAST + (j & 7) * 256;
}
__device__ __forceinline__ int tok_keyrow(int t) {
  if (t < NPT) return t;
  const int j = t - NPT; return 8192 + (j >> 11) * LKEYS + PAST + (j & 2047);
}
__device__ __forceinline__ int tok_modrow(int t) { return t < NPT ? 0 : 1 + ((t - NPT) >> 11); }
__device__ __forceinline__ float swap_add(float v) {
  auto rr = __builtin_amdgcn_permlane32_swap(__float_as_uint(v), __float_as_uint(v), false, false);
  return __uint_as_float(rr[0]) + __uint_as_float(rr[1]);
}
__device__ __forceinline__ float swap_max(float v) {
  auto rr = __builtin_amdgcn_permlane32_swap(__float_as_uint(v), __float_as_uint(v), false, false);
  return fmaxf(__uint_as_float(rr[0]), __uint_as_float(rr[1]));
}

__device__ __forceinline__ int lds_byte(int r, int c) { const int st = (r >> 4) * 2 + (c >> 5), rr = r & 15, cc = c & 31, ob = rr * 64 + cc * 2; return st * 1024 + (ob ^ (((ob >> 9) & 1) << 5)); }
__device__ __forceinline__ void stage_rc(int b, int& R, int& C) { const int st = b / 1024, sb = b % 1024, swz = sb ^ (((sb >> 9) & 1) << 5); R = (st >> 1) * 16 + swz / 64; C = (st & 1) * 32 + (swz % 64) / 2; }
constexpr int HTB = 16384, GSTAGE = 3 * HTB;
#define WAIT_V(n) asm volatile("s_waitcnt vmcnt(" #n ")" ::: "memory")
#define WAIT_L0() asm volatile("s_waitcnt lgkmcnt(0)" ::: "memory")
#define BAR() __builtin_amdgcn_s_barrier()

__device__ __forceinline__ void glds16(const half_t* src, LAS char* dst) {
  __builtin_amdgcn_global_load_lds((const unsigned*)src, (LAS unsigned*)dst, 16, 0, 0);
}

__device__ __forceinline__ int ltid() { int t = threadIdx.x; asm volatile("" : "+v"(t)); return t; }
__device__ __forceinline__ void gemm_kloop(f32x4 (&acc)[4][4], const half_t* __restrict__ A, int lda, const half_t* __restrict__ Bt, int ldb, int K, LAS char* lds) {
  const int tid = ltid(), lane = tid & 63, wid = tid >> 6, wr = wid >> 1, wc = wid & 1, fr = lane & 15, fq = lane >> 4;
  int R0, C0, R1, C1;
  stage_rc(tid * 16, R0, C0); stage_rc(tid * 16 + 8192, R1, C1);
  const unsigned oa0 = (unsigned)(R0 * lda + C0) * 2u, oa1 = (unsigned)(R1 * lda + C1) * 2u;
  const unsigned ob0 = (unsigned)(R0 * ldb + C0) * 2u, ob1 = (unsigned)(R1 * ldb + C1) * 2u;
  const char* Ab = (const char*)A; const char* Ab1 = Ab + (size_t)128 * lda * 2; const char* Bb = (const char*)Bt;
  LAS char* d0 = lds + tid * 16;
  const int nt = K >> 6;
  const int aoff0 = (wr >> 1) * HTB + lds_byte((wr & 1) * 64 + fr, fq * 8), boff0 = 2 * HTB + lds_byte(wc * 64 + fr, fq * 8);
#define GSTG(kt, buf) do { LAS char* d_ = d0 + (buf) * GSTAGE; const size_t ko_ = (size_t)(kt) * 128; \
    glds16((const half_t*)(Ab + ko_ + oa0), d_); glds16((const half_t*)(Ab + ko_ + oa1), d_ + 8192); \
    glds16((const half_t*)(Ab1 + ko_ + oa0), d_ + HTB); glds16((const half_t*)(Ab1 + ko_ + oa1), d_ + HTB + 8192); \
    glds16((const half_t*)(Bb + ko_ + ob0), d_ + 2 * HTB); glds16((const half_t*)(Bb + ko_ + ob1), d_ + 2 * HTB + 8192); } while (0)
  GSTG(0, 0);
  for (int t = 0; t < nt; ++t) {
    if (t + 1 < nt) { GSTG(t + 1, (t + 1) & 1); WAIT_V(6); } else { WAIT_V(0); }
    BAR();
    LAS char* base = lds + (t & 1) * GSTAGE;
#pragma unroll
    for (int kk = 0; kk < 2; ++kk) {
      half8 a[4], b[4];
#pragma unroll
      for (int m = 0; m < 4; ++m) { a[m] = *(LAS half8*)(base + aoff0 + m * 2048 + kk * 1024); b[m] = *(LAS half8*)(base + boff0 + m * 2048 + kk * 1024); }
#pragma unroll
      for (int m = 0; m < 4; ++m)
#pragma unroll
        for (int n = 0; n < 4; ++n) acc[m][n] = __builtin_amdgcn_mfma_f32_16x16x32_f16(b[n], a[m], acc[m][n], 0, 0, 0);
    }
    WAIT_L0(); BAR();
  }
#undef GSTG
}
__device__ __forceinline__ void zero_acc(f32x4 (&acc)[4][4]) {
#pragma unroll
  for (int m = 0; m < 4; ++m)
#pragma unroll
    for (int n = 0; n < 4; ++n) acc[m][n] = (f32x4){0.f, 0.f, 0.f, 0.f};
}
#define EPI_COORDS const int tid = ltid(), lane = tid & 63, wid = tid >> 6, wr = wid >> 1, wc = wid & 1, fr = lane & 15, fq = lane >> 4; (void)wr; (void)wc; (void)fr; (void)fq;

__device__ void transpose_tile(const float* __restrict__ src, int lds_src, int Ksrc, half_t* __restrict__ dst, int Kdst, int n0, int k0, int colshift_mode, LAS char* lds) {
  LAS float* tile = (LAS float*)lds;
  const int tid = ltid();
  const int c4 = (tid & 15) * 4;
#pragma unroll
  for (int i = 0; i < 2; ++i) {
    const int kk = (tid >> 4) + i * 32;
    const int n = n0 + c4;
    int col = n; bool valid = (k0 + kk) < Ksrc;
    if (colshift_mode == 1) { if (n >= 416 && n < 512) valid = false; else if (n >= 512) col = n - 96; }
    f32x4 v = (f32x4){0.f, 0.f, 0.f, 0.f};
    if (valid) v = *(const f32x4*)(src + (size_t)(k0 + kk) * lds_src + col);
    tile[kk * 65 + c4 + 0] = v[0]; tile[kk * 65 + c4 + 1] = v[1]; tile[kk * 65 + c4 + 2] = v[2]; tile[kk * 65 + c4 + 3] = v[3];
  }
  __syncthreads();
  {
    const int n = tid >> 3, kc = (tid & 7) * 8;
    half8 h;
#pragma unroll
    for (int j = 0; j < 8; ++j) h[j] = (half_t)tile[(kc + j) * 65 + n];
    *(half8*)(dst + (size_t)(n0 + n) * Kdst + k0 + kc) = h;
  }
  __syncthreads();
}

__device__ void phase_prologue(const Params& P, LAS char* lds) {
  const int tid = ltid();
  char* ws = P.ws;
  constexpr int T_WIN = (NW1 / 64) * 16, T_WQB = 12 * 4, T_WKVB = 16 * 4, T_WGLU = 8 * 8, T_WBR = 4 * 16 * 8, T_WOUT = 16 * 16;
  constexpr int T_LAYER = T_WIN + T_WQB + T_WKVB + T_WGLU + T_WBR + T_WOUT;
  constexpr int U_TR = 2 * T_LAYER, U_MOD = 192, U_SSM = 16, U_ROPE = 192;
  constexpr int U_ALL = U_TR + U_MOD + U_SSM + U_ROPE;
  for (int u = blockIdx.x; u < U_ALL; u += gridDim.x) {
    if (u < U_TR) {
      const int l = u / T_LAYER; int r = u % T_LAYER;
      if (r < T_WIN) { transpose_tile(P.in[I_WIN] + (size_t)l * 1024 * D_IN, D_IN, 1024, (half_t*)(ws + WS_WIN) + (size_t)l * NW1 * 1024, 1024, (r >> 4) * 64, (r & 15) * 64, 1, lds); continue; }
      r -= T_WIN;
      if (r < T_WQB) { transpose_tile(P.in[I_WQB] + (size_t)l * 256 * 768, 768, 256, (half_t*)(ws + WS_WQB) + (size_t)l * 768 * 256, 256, (r >> 2) * 64, (r & 3) * 64, 0, lds); continue; }
      r -= T_WQB;
      if (r < T_WKVB) { transpose_tile(P.in[I_WKVB] + (size_t)l * 128 * 1024, 1024, 128, (half_t*)(ws + WS_WKVB) + (size_t)l * 1024 * 256, 256, (r >> 2) * 64, (r & 3) * 64, 0, lds); continue; }
      r -= T_WKVB;
      if (r < T_WGLU) { transpose_tile(P.in[I_GLUW] + (size_t)l * 512 * 512, 512, 512, (half_t*)(ws + WS_WGLU) + (size_t)l * 512 * 512, 512, (r >> 3) * 64, (r & 7) * 64, 0, lds); continue; }
      r -= T_WGLU;
      if (r < T_WBR) { const int n = r / 128, rr = r % 128;
        transpose_tile(P.in[I_WBR] + ((size_t)l * 4 + n) * 512 * 1024, 1024, 512, (half_t*)(ws + WS_WBR) + ((size_t)l * 4 + n) * 1024 * 512, 512, (rr >> 3) * 64, (rr & 7) * 64, 0, lds); continue; }
      r -= T_WBR;
      transpose_tile(P.in[I_WOUT] + (size_t)l * 1024 * 1024, 1024, 1024, (half_t*)(ws + WS_WOUT) + (size_t)l * 1024 * 1024, 1024, (r >> 4) * 64, (r & 15) * 64, 0, lds);
      continue;
    }
    int v = u - U_TR;
    if (v < U_MOD) {
      const int l = v / 96, n0 = (v % 96) * 32;
      const int nn = tid & 31, ks = tid >> 5;
      const float* w = P.in[I_WMOD] + (size_t)l * 1024 * 3072 + n0 + nn;
      float s0 = 0.f, s1 = 0.f, s2 = 0.f;
      for (int k = ks * 64; k < ks * 64 + 64; ++k) {
        const float wv = w[(size_t)k * 3072];
        s0 += siluf_(P.in[I_CCTX][k]) * wv; s1 += siluf_(P.in[I_C][k]) * wv; s2 += siluf_(P.in[I_C][1024 + k]) * wv;
      }
      LAS float* red = (LAS float*)lds;
      red[(0 * 16 + ks) * 32 + nn] = s0; red[(1 * 16 + ks) * 32 + nn] = s1; red[(2 * 16 + ks) * 32 + nn] = s2;
      __syncthreads();
      if (tid < 96) {
        const int r = tid >> 5, n = tid & 31; float s = 0.f;
        for (int k = 0; k < 16; ++k) s += red[(r * 16 + k) * 32 + n];
        ((float*)(ws + WS_MOD))[((size_t)l * 3 + r) * 3072 + n0 + n] = s + P.in[I_BMOD][(size_t)l * 3072 + n0 + n];
      }
      __syncthreads();
      continue;
    }
    v -= U_MOD;
    if (v < U_SSM) {
      const int e = v * 512 + tid;
      const int p = e & 63, idx = e >> 6;
      const double are = P.in[I_ARE][e], aim = P.in[I_AIM][e];
      const double dt = exp((double)P.in[I_LOGDT][idx]);
      const double mag = exp(are * dt), ang = aim * dt;
      const double abr = mag * cos(ang), abi = mag * sin(ang);
      const double nr = abr - 1.0, ni = abi, den = are * are + aim * aim;
      const double cr = (nr * are + ni * aim) / den, ci = (ni * are - nr * aim) / den;
      float* ab = (float*)(ws + WS_ABAR); ab[e * 2] = (float)abr; ab[e * 2 + 1] = (float)abi;
      const float sc = exp2f(ceilf(-log2f((float)dt)));
      if (p == 0) ((float*)(ws + WS_BSC))[idx] = 1.0f / sc;
      half_t* bm = (half_t*)(ws + WS_BM) + (size_t)idx * 2048;
      half_t* cm = (half_t*)(ws + WS_CM) + (size_t)idx * 2048;
      for (int n = 0; n < 16; ++n) {
        const double br = P.in[I_BRE][(size_t)e * 16 + n], bi = P.in[I_BIM][(size_t)e * 16 + n];
        bm[p * 16 + n] = (half_t)(float)((cr * br - ci * bi) * sc);
        bm[(64 + p) * 16 + n] = (half_t)(float)((cr * bi + ci * br) * sc);
        cm[n * 128 + p] = (half_t)P.in[I_CRE][((size_t)idx * 16 + n) * 64 + p];
        cm[n * 128 + 64 + p] = (half_t)(-P.in[I_CIM][((size_t)idx * 16 + n) * 64 + p]);
      }
      if (v == 0 && tid < 2) {
        const int l = tid; float a = 0.f, b = 0.f;
        for (int i = 0; i < 64; ++i) { a += P.in[I_LQ1][l * 64 + i] * P.in[I_LK1][l * 64 + i]; b += P.in[I_LQ2][l * 64 + i] * P.in[I_LK2][l * 64 + i]; }
        const float lam_init = 0.8f - 0.6f * expf(-0.3f * (float)l);
        ((float*)(ws + WS_LAM))[l] = expf(a) - expf(b) + lam_init;
      }
      continue;
    }
    v -= U_SSM;
    {
      const int e = v * 512 + tid;
      const int s = e / 48, j = e % 48;
      const float row = (float)(s >> 6), col = (float)(s & 63);
      if (j < 32) {
        const int q = j & 15; const float inv = powf(10000.0f, -(float)q / 16.0f);
        const float ang = (j < 16 ? row : col) * inv; float sn, cs; sincosf(ang, &sn, &cs);
        float* t = (float*)(ws + WS_ROPE64) + ((size_t)s * 32 + j) * 2; t[0] = cs; t[1] = sn;
      } else {
        const int jj = j - 32, q = jj & 7; const float inv = powf(10000.0f, -(float)q / 8.0f);
        const float ang = (jj < 8 ? row : col) * inv; float sn, cs; sincosf(ang, &sn, &cs);
        float* t = (float*)(ws + WS_ROPE32) + ((size_t)s * 16 + jj) * 2; t[0] = cs; t[1] = sn;
      }
    }
  }
}

__device__ __forceinline__ const float* xin_row(const Params& P, int l, int row) {
  if (l == 0) return row < NPT ? P.in[I_XP] + (size_t)row * DM : P.in[I_XS] + (size_t)(row - NPT) * DM;
  return P.out + (size_t)row * DM;
}
__device__ void phase_norm(const Params& P, int l) {
  const int tid_ = ltid(), lane = tid_ & 63, wid = tid_ >> 6;
  const float* g = P.in[I_NORMG] + l * DM;
  for (int row = blockIdx.x * 8 + wid; row < NTOK; row += gridDim.x * 8) {
    const float* x = xin_row(P, l, row);
    const float* mod = (const float*)(P.ws + WS_MOD) + ((size_t)l * 3 + tok_modrow(row)) * 3072;
    f32x4 v[4]; float ss = 0.f;
#pragma unroll
    for (int i = 0; i < 4; ++i) { v[i] = *(const f32x4*)(x + i * 256 + lane * 4); ss += v[i][0] * v[i][0] + v[i][1] * v[i][1] + v[i][2] * v[i][2] + v[i][3] * v[i][3]; }
    ss = wave_sum(ss);
    const float rstd = rsqrtf(ss * (1.0f / DM) + EPS);
    half_t* h = (half_t*)(P.ws + WS_H) + (size_t)row * DM;
#pragma unroll
    for (int i = 0; i < 4; ++i) {
      const int c = i * 256 + lane * 4;
      const f32x4 gg = *(const f32x4*)(g + c), sh = *(const f32x4*)(mod + c), sc = *(const f32x4*)(mod + 1024 + c);
      f32x4 o;
#pragma unroll
      for (int j = 0; j < 4; ++j) o[j] = v[i][j] * rstd * gg[j] * (1.0f + sc[j]) + sh[j];
      *(half4*)(h + c) = to_half4(o);
    }
  }
}
__device__ void phase_final(const Params& P) {
  const int tid_ = ltid(), lane = tid_ & 63, wid = tid_ >> 6;
  const float* g = P.in[I_FNORM];
  for (int row = blockIdx.x * 8 + wid; row < NTOK; row += gridDim.x * 8) {
    float* x = P.out + (size_t)row * DM;
    f32x4 v[4]; float ss = 0.f;
#pragma unroll
    for (int i = 0; i < 4; ++i) { v[i] = *(const f32x4*)(x + i * 256 + lane * 4); ss += v[i][0] * v[i][0] + v[i][1] * v[i][1] + v[i][2] * v[i][2] + v[i][3] * v[i][3]; }
    ss = wave_sum(ss);
    const float rstd = rsqrtf(ss * (1.0f / DM) + EPS);
#pragma unroll
    for (int i = 0; i < 4; ++i) {
      const int c = i * 256 + lane * 4;
      const f32x4 gg = *(const f32x4*)(g + c);
      f32x4 o;
#pragma unroll
      for (int j = 0; j < 4; ++j) o[j] = v[i][j] * rstd * gg[j];
      *(f32x4*)(x + c) = o;
    }
  }
}

__device__ void phase_gemm1(const Params& P, int l, LAS char* lds) {
  const half_t* H = (const half_t*)(P.ws + WS_H);
  const half_t* W = (const half_t*)(P.ws + WS_WIN) + (size_t)l * NW1 * 1024;
  half_t* P1 = (half_t*)(P.ws + WS_P1); half_t* SG = (half_t*)(P.ws + WS_SG);
  constexpr int NCT = 42, NU = 48 * NCT;
  for (int u = blockIdx.x; u < NU; u += gridDim.x) {
    const int ct = u / 48, rt = u % 48;
    f32x4 acc[4][4]; zero_acc(acc);
    gemm_kloop(acc, H + (size_t)rt * 256 * 1024, 1024, W + (size_t)ct * 128 * 1024, 1024, 1024, lds);
    EPI_COORDS
    const int kr0 = tile_keyrow(rt);
#pragma unroll
    for (int m = 0; m < 4; ++m) {
      const int r = wr * 64 + m * 16 + fr;
#pragma unroll
      for (int n = 0; n < 4; ++n) {
        const int c = ct * 128 + wc * 64 + n * 16 + fq * 4;
        if (ct < 26) { *(half4*)(P1 + (size_t)(kr0 + r) * P1W + c) = to_half4(acc[m][n]); }
        else { f32x4 v = acc[m][n]; v[0] = siluf_(v[0]); v[1] = siluf_(v[1]); v[2] = siluf_(v[2]); v[3] = siluf_(v[3]);
               *(half4*)(SG + (size_t)(rt * 256 + r) * SGW + (c - P1W)) = to_half4(v); }
      }
    }
  }
}

constexpr int ROWBUF = 3328 * 4;
__device__ void phase_post(const Params& P, int l, LAS char* lds) {
  const int tid_ = ltid(), lane = tid_ & 63, wid = tid_ >> 6;
  LAS float* rb = (LAS float*)(lds + wid * ROWBUF);
  half_t* P1 = (half_t*)(P.ws + WS_P1);
  float* out = P.out;
  constexpr int NROWS = NTOK + 2 * PAST;
  for (int it = blockIdx.x * 8 + wid; it < NROWS; it += gridDim.x * 8) {
    if (it >= NTOK) {
      const int j = it - NTOK, b = j >> 9, s = j & 511;
      half_t* row = P1 + (size_t)(8192 + b * LKEYS + s) * P1W;
      const size_t cb = ((size_t)b * 2 + l) * PAST + s;
      const float* ckv = P.in[I_CCKV] + cb * 128; const float* kro = P.in[I_CKROPE] + cb * 32;
      const float* dk = P.in[I_CDK] + cb * 512;   const float* dv = P.in[I_CDV] + cb * 512;
      const float* gk = P.in[I_CGK] + cb * 128;   const float* gv = P.in[I_CGV] + cb * 128;
      for (int c = lane; c < 128; c += 64) { row[C_KVA + c] = (half_t)ckv[c]; row[C_GK + c] = (half_t)gk[c]; row[C_GV + c] = (half_t)gv[c]; }
      for (int c = lane; c < 128; c += 64) row[C_KPE + c] = (half_t)(c < 32 ? kro[c] : 0.f);
      for (int c = lane; c < 512; c += 64) { row[C_DK + c] = (half_t)dk[c]; row[C_DV + c] = (half_t)dv[c]; }
      continue;
    }
    const int t = it; const bool latent = t >= NPT;
    half_t* row = P1 + (size_t)tok_keyrow(t) * P1W;
#pragma unroll
    for (int i = 0; i < 7; ++i) {
      const int c = i * 512 + lane * 8;
      if (c < P1W) { const half8 h = *(const half8*)(row + c);
#pragma unroll
        for (int j = 0; j < 8; ++j) rb[c + j] = (float)h[j]; }
    }
    const int pos = latent ? ((t - NPT) & 2047) : 0;
    const float* r64 = (const float*)(P.ws + WS_ROPE64) + (size_t)pos * 64;
    const float* r32 = (const float*)(P.ws + WS_ROPE32) + (size_t)pos * 32;
    const int pb = t >> 8, ps = t & 255;
    const size_t sidx = ((size_t)pb * 2 + l) * 256 + ps;
    {
      float v[4], ss = 0.f;
#pragma unroll
      for (int i = 0; i < 4; ++i) { v[i] = rb[C_QA + i * 64 + lane]; ss += v[i] * v[i]; }
      ss = wave_sum(ss); const float rstd = rsqrtf(ss * (1.0f / 256.0f) + EPS);
#pragma unroll
      for (int i = 0; i < 4; ++i) row[C_QA + i * 64 + lane] = (half_t)(v[i] * rstd * P.in[I_QNORM][l * 256 + i * 64 + lane]);
    }
    {
      float v[2], ss = 0.f;
#pragma unroll
      for (int i = 0; i < 2; ++i) { v[i] = rb[C_KVA + i * 64 + lane]; ss += v[i] * v[i]; }
      ss = wave_sum(ss); const float rstd = rsqrtf(ss * (1.0f / 128.0f) + EPS);
#pragma unroll
      for (int i = 0; i < 2; ++i) { const float o = v[i] * rstd * P.in[I_KVNORM][l * 128 + i * 64 + lane];
        row[C_KVA + i * 64 + lane] = (half_t)o; if (!latent) out[O_CKV + sidx * 128 + i * 64 + lane] = o; }
    }
    if (lane < 16) {
      const float x1 = rb[C_KPE + lane], x2 = rb[C_KPE + 16 + lane];
      if (latent) { const float c = r32[lane * 2], s = r32[lane * 2 + 1]; row[C_KPE + lane] = (half_t)(x1 * c - x2 * s); row[C_KPE + 16 + lane] = (half_t)(x1 * s + x2 * c); }
      else { out[O_KROPE + sidx * 32 + lane] = x1; out[O_KROPE + sidx * 32 + 16 + lane] = x2; }
    }
    {
      const float qs = 0.125f * LOG2E;
      const int j = lane & 31, hh = lane >> 5;
      const float c = latent ? r64[j * 2] : 1.f, s = latent ? r64[j * 2 + 1] : 0.f;
#pragma unroll
      for (int i = 0; i < 8; ++i) {
        const int h = i * 2 + hh;
        const int base = C_DQ + h * 64;
        const float x1 = rb[base + j], x2 = rb[base + 32 + j];
        const float o1 = x1 * c - x2 * s, o2 = x1 * s + x2 * c;
        if (h < 8) { row[base + j] = (half_t)(o1 * qs); row[base + 32 + j] = (half_t)(o2 * qs); }
        else { if (latent) { row[base + j] = (half_t)o1; row[base + 32 + j] = (half_t)o2; }
               else { out[O_DK + sidx * 512 + (h - 8) * 64 + j] = x1; out[O_DK + sidx * 512 + (h - 8) * 64 + 32 + j] = x2; } }
      }
    }
    if (!latent) {
#pragma unroll
      for (int i = 0; i < 8; ++i) out[O_DV + sidx * 512 + i * 64 + lane] = rb[C_DV + i * 64 + lane];
#pragma unroll
      for (int i = 0; i < 2; ++i) out[O_GV + sidx * 128 + i * 64 + lane] = rb[C_GV + i * 64 + lane];
    }
    {
      const int j = lane & 31;
      const float c = latent ? r64[j * 2] : 1.f, s = latent ? r64[j * 2 + 1] : 0.f;
      const float gqn = P.in[I_GQN][l * 64 + lane], gkn = P.in[I_GKN][l * 64 + lane];
#pragma unroll
      for (int h = 0; h < 10; ++h) {
        const int base = (h < 8) ? C_GQ + h * 64 : C_GK + (h - 8) * 64;
        float v = rb[base + lane];
        const float ss = wave_sum(v * v);
        v = v * rsqrtf(ss * (1.0f / 64.0f) + EPS) * (h < 8 ? gqn : gkn);
        const float pv = __shfl_xor(v, 32);
        float o = v;
        if (latent) o = (lane < 32) ? (v * c - pv * s) : (pv * s + v * c);
        if (h < 8) row[base + lane] = (half_t)(o * (0.125f * LOG2E));
        else { row[base + lane] = (half_t)o; if (!latent) out[O_GK + sidx * 128 + (h - 8) * 64 + lane] = o; }
      }
    }
  }
}

__device__ void phase_gemm2(const Params& P, int l, LAS char* lds) {
  const half_t* P1 = (const half_t*)(P.ws + WS_P1);
  const half_t* WQ = (const half_t*)(P.ws + WS_WQB) + (size_t)l * 768 * 256;
  const half_t* WK = (const half_t*)(P.ws + WS_WKVB) + (size_t)l * 1024 * 256;
  half_t* QA = (half_t*)(P.ws + WS_QA); half_t* KVA = (half_t*)(P.ws + WS_KVA);
  constexpr int NUQ = 48 * 6, NUK = 52 * 8;
  const float qscale = 0.10206207261596575f * LOG2E;
  for (int u = blockIdx.x; u < NUQ + NUK; u += gridDim.x) {
    f32x4 acc[4][4]; zero_acc(acc);
    if (u < NUQ) {
      const int ct = u / 48, rt = u % 48;
      gemm_kloop(acc, P1 + (size_t)tile_keyrow(rt) * P1W + C_QA, P1W, WQ + (size_t)ct * 128 * 256, 256, 256, lds);
      EPI_COORDS
      const bool latent = rt >= 32;
#pragma unroll
      for (int m = 0; m < 4; ++m) {
        const int r = rt * 256 + wr * 64 + m * 16 + fr;
        const float* r32 = (const float*)(P.ws + WS_ROPE32) + (size_t)(latent ? ((r - NPT) & 2047) : 0) * 32;
#pragma unroll
        for (int np = 0; np < 2; ++np) {
          const int cb = ct * 128 + wc * 64 + np * 32;
          f32x4 v0 = acc[m][np * 2], v1 = acc[m][np * 2 + 1];
          if (latent && (cb % 96) == 64) {
#pragma unroll
            for (int j = 0; j < 4; ++j) { const int a = fq * 4 + j; const float c = r32[a * 2], s = r32[a * 2 + 1];
              const float x1 = v0[j], x2 = v1[j]; v0[j] = x1 * c - x2 * s; v1[j] = x1 * s + x2 * c; }
          }
          v0 = v0 * qscale; v1 = v1 * qscale;
          *(half4*)(QA + (size_t)r * 768 + cb + fq * 4) = to_half4(v0);
          *(half4*)(QA + (size_t)r * 768 + cb + 16 + fq * 4) = to_half4(v1);
        }
      }
    } else {
      const int v = u - NUQ, ct = v / 52, rt = v % 52;
      gemm_kloop(acc, P1 + (size_t)rt * 256 * P1W + C_KVA, P1W, WK + (size_t)ct * 128 * 256, 256, 256, lds);
      EPI_COORDS
#pragma unroll
      for (int m = 0; m < 4; ++m) {
        const int r = rt * 256 + wr * 64 + m * 16 + fr;
#pragma unroll
        for (int n = 0; n < 4; ++n) *(half4*)(KVA + (size_t)r * 1024 + ct * 128 + wc * 64 + n * 16 + fq * 4) = to_half4(acc[m][n]);
      }
    }
  }
}

__device__ __forceinline__ int crow(int r, int hi) { return (r & 3) + 8 * (r >> 2) + 4 * hi; }
constexpr int KSTR = 64 * 16 + 16;
template <int NCH1, int NCH2, int DV>
__device__ __forceinline__ void attn_pass(const half_t* __restrict__ Q, int ldq, const half_t* __restrict__ K1, int ldk1, const half_t* __restrict__ K2, int ldk2,
                                          const half_t* __restrict__ V, int ldv, int nkeys, LAS char* lds, f32x16 (&o)[DV / 32], float& linv) {
  constexpr int NCH = NCH1 + NCH2, ND0 = NCH / 2, NDB = DV / 32;
  constexpr int KB = ((NCH * KSTR + 255) / 256) * 256, VB = NDB * 4096, BUFB = KB + VB;
  constexpr int KP = (64 * NCH + 511) / 512, VP = (64 * DV / 8) / 512;
  const int tid = ltid(), lane = tid & 63, wid = tid >> 6, r32 = lane & 31, hi = lane >> 5;
  half8 qf[ND0];
  {
    const half_t* qp = Q + (size_t)(wid * 32 + r32) * ldq + hi * 8;
#pragma unroll
    for (int d0 = 0; d0 < ND0; ++d0) qf[d0] = *(const half8*)(qp + d0 * 16);
  }
  half8 kreg[KP], vreg[VP];
  int kdst[KP], vdst[VP]; const half_t* ksrc[KP]; const half_t* vsrc[VP]; int kstep[KP];
#pragma unroll
  for (int i = 0; i < KP; ++i) {
    const int idx = tid + i * 512; const int key = idx / NCH, ch = idx % NCH;
    kdst[i] = ch * KSTR + key * 16;
    if (ch < NCH1) { ksrc[i] = K1 + (size_t)key * ldk1 + ch * 8; kstep[i] = 64 * ldk1; }
    else { ksrc[i] = K2 + (size_t)key * ldk2 + (ch - NCH1) * 8; kstep[i] = 64 * ldk2; }
  }
#pragma unroll
  for (int i = 0; i < VP; ++i) {
    const int idx = tid + i * 512; const int key = idx / (DV / 8), c = idx % (DV / 8);
    vdst[i] = KB + (c >> 2) * 4096 + key * 64 + (c & 3) * 16;
    vsrc[i] = V + (size_t)key * ldv + c * 8;
  }
  const int nt = nkeys >> 6;
#define AT_GLOAD(t) do { _Pragma("unroll") for (int i = 0; i < KP; ++i) if (tid + i * 512 < 64 * NCH) kreg[i] = *(const half8*)(ksrc[i] + (size_t)(t) * kstep[i]); \
                         _Pragma("unroll") for (int i = 0; i < VP; ++i) vreg[i] = *(const half8*)(vsrc[i] + (size_t)(t) * 64 * ldv); } while (0)
#define AT_LSTORE(buf) do { _Pragma("unroll") for (int i = 0; i < KP; ++i) if (tid + i * 512 < 64 * NCH) *(LAS half8*)(lds + (buf) * BUFB + kdst[i]) = kreg[i]; \
                            _Pragma("unroll") for (int i = 0; i < VP; ++i) *(LAS half8*)(lds + (buf) * BUFB + vdst[i]) = vreg[i]; } while (0)
  AT_GLOAD(0); AT_LSTORE(0);
  __syncthreads();
  float mrun = -1e30f, lrun = 0.f;
#pragma unroll
  for (int d = 0; d < NDB; ++d)
#pragma unroll
    for (int r = 0; r < 16; ++r) o[d][r] = 0.f;
  const int koff = hi * KSTR + r32 * 16;
  const int voff = KB + (4 * hi + ((lane & 15) >> 2)) * 64 + ((lane >> 4) & 1) * 32 + (lane & 3) * 8;
  for (int t = 0; t < nt; ++t) {
    if (t + 1 < nt) AT_GLOAD(t + 1);
    LAS char* kb = lds + (t & 1) * BUFB;
    f32x16 p0, p1;
#pragma unroll
    for (int r = 0; r < 16; ++r) { p0[r] = 0.f; p1[r] = 0.f; }
#pragma unroll
    for (int d0 = 0; d0 < ND0; ++d0) {
      const half8 k0 = *(LAS half8*)(kb + koff + d0 * 2 * KSTR);
      const half8 k1 = *(LAS half8*)(kb + koff + d0 * 2 * KSTR + 512);
      p0 = __builtin_amdgcn_mfma_f32_32x32x16_f16(k0, qf[d0], p0, 0, 0, 0);
      p1 = __builtin_amdgcn_mfma_f32_32x32x16_f16(k1, qf[d0], p1, 0, 0, 0);
      if (NDB > 2 && (d0 & 1)) __builtin_amdgcn_sched_barrier(0);
    }
    float mx = fmaxf(p0[0], p1[0]);
#pragma unroll
    for (int r = 1; r < 16; ++r) mx = fmaxf(mx, fmaxf(p0[r], p1[r]));
    mx = swap_max(mx);
    const float mnew = fmaxf(mrun, mx);
    const float alpha = exp2f(mrun - mnew);
    mrun = mnew;
    float ps = 0.f;
#pragma unroll
    for (int r = 0; r < 16; ++r) { p0[r] = exp2f(p0[r] - mnew); p1[r] = exp2f(p1[r] - mnew); ps += p0[r] + p1[r]; }
    lrun = lrun * alpha + ps;
#pragma unroll
    for (int d = 0; d < NDB; ++d)
#pragma unroll
      for (int r = 0; r < 16; ++r) o[d][r] *= alpha;
    half8 pb[4];
    if (NDB > 2) __builtin_amdgcn_sched_barrier(0);
#pragma unroll
    for (int j = 0; j < 8; ++j) { pb[0][j] = (half_t)p0[j]; pb[1][j] = (half_t)p0[8 + j]; pb[2][j] = (half_t)p1[j]; pb[3][j] = (half_t)p1[8 + j]; }
#pragma unroll
    for (int d = 0; d < NDB; ++d) {
#pragma unroll
      for (int s = 0; s < 4; ++s) {
        const v4i16_t lo = __builtin_amdgcn_ds_read_tr16_b64_v4i16((LAS v4i16_t*)(kb + voff + d * 4096 + s * 1024));
        const v4i16_t hh = __builtin_amdgcn_ds_read_tr16_b64_v4i16((LAS v4i16_t*)(kb + voff + d * 4096 + s * 1024 + 512));
        typedef short s16x8 __attribute__((ext_vector_type(8)));
        const s16x8 vv = (s16x8){lo[0], lo[1], lo[2], lo[3], hh[0], hh[1], hh[2], hh[3]};
        o[d] = __builtin_amdgcn_mfma_f32_32x32x16_f16(__builtin_bit_cast(half8, vv), pb[s], o[d], 0, 0, 0);
      }
      if (NDB > 2) __builtin_amdgcn_sched_barrier(0);
    }
    if (t + 1 < nt) AT_LSTORE((t + 1) & 1);
    __syncthreads();
  }
#undef AT_GLOAD
#undef AT_LSTORE
  linv = 1.0f / swap_add(lrun);
}

struct AttnGeom { int tok0, key0, nkeys, mrow; };
__device__ __forceinline__ AttnGeom attn_geom(bool latent, int b, int qb) {
  AttnGeom g;
  if (latent) { g.tok0 = NPT + b * LSEQ + qb * 256; g.key0 = 8192 + b * LKEYS; g.nkeys = LKEYS; }
  else { g.tok0 = b * 256; g.key0 = b * 256; g.nkeys = 256; }
  g.mrow = 0; return g;
}

__device__ void mla_unit(const Params& P, bool latent, int b, int qb, int h, LAS char* lds) {
  const AttnGeom g = attn_geom(latent, b, qb);
  const half_t* QA = (const half_t*)(P.ws + WS_QA) + (size_t)g.tok0 * 768 + h * 96;
  const half_t* KVA = (const half_t*)(P.ws + WS_KVA) + (size_t)g.key0 * 1024 + h * 128;
  const half_t* P1 = (const half_t*)(P.ws + WS_P1) + (size_t)g.key0 * P1W;
  f32x16 o[2]; float linv;
  attn_pass<8, 4, 64>(QA, 768, KVA, 1024, P1 + C_KPE, P1W, KVA + 64, 1024, g.nkeys, lds, o, linv);
  const int tid_ = ltid(), lane = tid_ & 63, wid = tid_ >> 6, r32 = lane & 31, hi = lane >> 5;
  half_t* sg = (half_t*)(P.ws + WS_SG) + (size_t)(g.tok0 + wid * 32 + r32) * SGW + 0 * 512 + h * 64;
#pragma unroll
  for (int d = 0; d < 2; ++d)
#pragma unroll
    for (int q = 0; q < 4; ++q) {
      half_t* p = sg + d * 32 + q * 8 + hi * 4;
      const f32x4 gv = to_f32x4(*(const half4*)p);
      f32x4 v; v[0] = o[d][q * 4] * linv * gv[0]; v[1] = o[d][q * 4 + 1] * linv * gv[1]; v[2] = o[d][q * 4 + 2] * linv * gv[2]; v[3] = o[d][q * 4 + 3] * linv * gv[3];
      *(half4*)p = to_half4(v);
    }
}
__device__ void gqa_unit(const Params& P, bool latent, int b, int qb, int h, LAS char* lds) {
  const AttnGeom g = attn_geom(latent, b, qb);
  const half_t* P1 = (const half_t*)(P.ws + WS_P1);
  const half_t* Q = P1 + (size_t)tok_keyrow(g.tok0) * P1W + C_GQ + h * 64;
  const half_t* Kp = P1 + (size_t)g.key0 * P1W + C_GK + (h >> 2) * 64;
  const half_t* Vp = P1 + (size_t)g.key0 * P1W + C_GV + (h >> 2) * 64;
  f32x16 o[2]; float linv;
  attn_pass<8, 0, 64>(Q, P1W, Kp, P1W, Kp, P1W, Vp, P1W, g.nkeys, lds, o, linv);
  const int tid_ = ltid(), lane = tid_ & 63, wid = tid_ >> 6, r32 = lane & 31, hi = lane >> 5;
  half_t* sg = (half_t*)(P.ws + WS_SG) + (size_t)(g.tok0 + wid * 32 + r32) * SGW + 2 * 512 + h * 64;
#pragma unroll
  for (int d = 0; d < 2; ++d)
#pragma unroll
    for (int q = 0; q < 4; ++q) {
      half_t* p = sg + d * 32 + q * 8 + hi * 4;
      const f32x4 gv = to_f32x4(*(const half4*)p);
      f32x4 v; v[0] = o[d][q * 4] * linv * gv[0]; v[1] = o[d][q * 4 + 1] * linv * gv[1]; v[2] = o[d][q * 4 + 2] * linv * gv[2]; v[3] = o[d][q * 4 + 3] * linv * gv[3];
      *(half4*)p = to_half4(v);
    }
}
__device__ void diff_unit(const Params& P, int l, bool latent, int b, int qb, int h, LAS char* lds) {
  const AttnGeom g = attn_geom(latent, b, qb);
  const half_t* P1 = (const half_t*)(P.ws + WS_P1);
  const half_t* Qb = P1 + (size_t)tok_keyrow(g.tok0) * P1W + C_DQ + h * 128;
  const half_t* Kb = P1 + (size_t)g.key0 * P1W + C_DK + h * 128;
  const half_t* Vp = P1 + (size_t)g.key0 * P1W + C_DV + h * 128;
  f32x16 o2[4]; float l2;
  const int tid0 = ltid();
  LAS char* o1s = lds + 2 * 24832 + (tid0 >> 6) * 8192 + (tid0 & 63) * 16;
  {
    f32x16 o1[4]; float l1;
    attn_pass<8, 0, 128>(Qb, P1W, Kb, P1W, Kb, P1W, Vp, P1W, g.nkeys, lds, o1, l1);
#pragma unroll
    for (int d = 0; d < 4; ++d)
#pragma unroll
      for (int q = 0; q < 2; ++q) {
        half8 hv;
#pragma unroll
        for (int j = 0; j < 8; ++j) hv[j] = (half_t)(o1[d][q * 8 + j] * l1);
        *(LAS half8*)(o1s + (d * 2 + q) * 1024) = hv;
      }
  }
  attn_pass<8, 0, 128>(Qb + 64, P1W, Kb + 64, P1W, Kb + 64, P1W, Vp, P1W, g.nkeys, lds, o2, l2);
  const float lam = ((const float*)(P.ws + WS_LAM))[l];
  const float lam_init = 0.8f - 0.6f * expf(-0.3f * (float)l);
  const float l2l = l2 * lam;
  float ss = 0.f;
#pragma unroll
  for (int d = 0; d < 4; ++d)
#pragma unroll
    for (int q = 0; q < 2; ++q) {
      const half8 hv = *(LAS half8*)(o1s + (d * 2 + q) * 1024);
#pragma unroll
      for (int j = 0; j < 8; ++j) { const float v = (float)hv[j] - l2l * o2[d][q * 8 + j]; o2[d][q * 8 + j] = v; ss += v * v; }
    }
  ss = swap_add(ss);
  const float rstd = rsqrtf(ss * (1.0f / 128.0f) + EPS) * (1.0f - lam_init);
  const int tid_ = ltid(), lane = tid_ & 63, wid = tid_ >> 6, r32 = lane & 31, hi = lane >> 5;
  half_t* sg = (half_t*)(P.ws + WS_SG) + (size_t)(g.tok0 + wid * 32 + r32) * SGW + 1 * 512 + h * 128;
  const float* sub = P.in[I_SUBLN] + l * 128;
#pragma unroll
  for (int d = 0; d < 4; ++d)
#pragma unroll
    for (int q = 0; q < 4; ++q) {
      const int dv = d * 32 + q * 8 + hi * 4;
      half_t* p = sg + dv;
      const f32x4 gv = to_f32x4(*(const half4*)p);
      const f32x4 sb = *(const f32x4*)(sub + dv);
      f32x4 v;
#pragma unroll
      for (int j = 0; j < 4; ++j) v[j] = o2[d][q * 4 + j] * rstd * sb[j] * gv[j];
      *(half4*)p = to_half4(v);
    }
}

constexpr int SSM_BU = 16 * 528, SSM_HS = 16 * 272, SSM_W = SSM_BU + SSM_HS;
__device__ void ssm_unit(const Params& P, int l, bool latent, int b, int oct, LAS char* lds) {
  const int tid_ = ltid(), lane = tid_ & 63, wid = tid_ >> 6, fr = lane & 15, fq = lane >> 4;
  const int g = oct * 8 + wid;
  const int T = latent ? LSEQ : PSEQ;
  const int tok0 = latent ? NPT + b * LSEQ : b * PSEQ;
  const int krow0 = latent ? 8192 + b * LKEYS + PAST : b * PSEQ;
  LAS char* my = lds + wid * SSM_W;
  const half_t* P1 = (const half_t*)(P.ws + WS_P1);
  half_t* Y = (half_t*)(P.ws + WS_Y);
  f32x4 dco = *(const f32x4*)(P.in[I_SSMD] + l * 512 + g * 16 + fq * 4);
  for (int dir = 1; dir >= 0; --dir) {
    const int idx = (l * 2 + dir) * 32 + g;
    half4 bmf[8]; half8 cmf[4];
    const half_t* bm = (const half_t*)(P.ws + WS_BM) + (size_t)idx * 2048;
    const half_t* cm = (const half_t*)(P.ws + WS_CM) + (size_t)idx * 2048;
#pragma unroll
    for (int tl = 0; tl < 8; ++tl) bmf[tl] = *(const half4*)(bm + (tl * 16 + fr) * 16 + fq * 4);
#pragma unroll
    for (int ks = 0; ks < 4; ++ks) cmf[ks] = *(const half8*)(cm + fr * 128 + ks * 32 + fq * 8);
    const float bsc = ((const float*)(P.ws + WS_BSC))[idx];
    const float ar = ((const float*)(P.ws + WS_ABAR))[((size_t)idx * 64 + lane) * 2], ai = ((const float*)(P.ws + WS_ABAR))[((size_t)idx * 64 + lane) * 2 + 1];
    float hr = 0.f, hi_ = 0.f;
    if (latent) { const float* st = P.in[I_STATE] + ((((size_t)b * 2 + l) * 2 + dir) * 32 + g) * 128 + lane * 2; hr = st[0]; hi_ = st[1]; }
    const int nch = T >> 4;
    for (int ci = 0; ci < nch; ++ci) {
      const int c = dir ? nch - 1 - ci : ci, t0 = c * 16;
      const half4 uf = *(const half4*)(P1 + (size_t)(krow0 + t0 + fr) * P1W + C_U + g * 16 + fq * 4);
#pragma unroll
      for (int tl = 0; tl < 8; ++tl) {
        f32x4 d = (f32x4){0.f, 0.f, 0.f, 0.f};
        d = __builtin_amdgcn_mfma_f32_16x16x16f16(bmf[tl], uf, d, 0, 0, 0);
        *(LAS f32x4*)(my + fr * 528 + (tl * 16 + fq * 4) * 4) = d * bsc;
      }
      float br[16], bi[16];
#pragma unroll
      for (int tt = 0; tt < 16; ++tt) { br[tt] = *(LAS float*)(my + tt * 528 + lane * 4); bi[tt] = *(LAS float*)(my + tt * 528 + (64 + lane) * 4); }
#pragma unroll
      for (int tt = 0; tt < 16; ++tt) {
        const int t = dir ? 15 - tt : tt;
        const float nhr = ar * hr - ai * hi_ + br[t], nhi = ar * hi_ + ai * hr + bi[t];
        hr = nhr; hi_ = nhi;
        *(LAS half_t*)(my + SSM_BU + t * 272 + lane * 2) = (half_t)hr;
        *(LAS half_t*)(my + SSM_BU + t * 272 + (64 + lane) * 2) = (half_t)hi_;
      }
      f32x4 yv = (f32x4){0.f, 0.f, 0.f, 0.f};
#pragma unroll
      for (int ks = 0; ks < 4; ++ks) {
        const half8 hs = *(LAS half8*)(my + SSM_BU + fr * 272 + (ks * 32 + fq * 8) * 2);
        yv = __builtin_amdgcn_mfma_f32_16x16x32_f16(cmf[ks], hs, yv, 0, 0, 0);
      }
      half_t* yp = Y + (size_t)(tok0 + t0 + fr) * 512 + g * 16 + fq * 4;
      if (dir == 1) { *(half4*)yp = to_half4(yv); }
      else {
        const unsigned long long pv = __hip_atomic_load((const unsigned long long*)yp, __ATOMIC_RELAXED, __HIP_MEMORY_SCOPE_AGENT);
        const f32x4 prev = to_f32x4(__builtin_bit_cast(half4, pv));
        const f32x4 uu = to_f32x4(uf);
        f32x4 o;
#pragma unroll
        for (int j = 0; j < 4; ++j) o[j] = gelu_tanh(yv[j] + prev[j] + dco[j] * uu[j]);
        *(half4*)yp = to_half4(o);
      }
    }
    if (!latent) { float* so = P.out + O_ST + ((((size_t)b * 2 + l) * 2 + dir) * 32 + g) * 128 + lane * 2; so[0] = hr; so[1] = hi_; }
  }
}

__device__ void phase_mix(const Params& P, int l, LAS char* lds) {
  constexpr int U0 = 8, U1 = U0 + 64, U2 = U1 + 128, U3 = U2 + 128, U4 = U3 + 128, U5 = U4 + 256, U6 = U5 + 256, U7 = U6 + 128;
  unsigned* ctr = (unsigned*)(P.ws + WS_CTRL) + 1024 + l * 64;
  LAS int* slot = (LAS int*)(lds + LDS_BYTES - 16);
  for (;;) {
    __syncthreads();
    if (threadIdx.x == 0) *slot = (int)atomicAdd(ctr, 1u);
    __syncthreads();
    const int u = *slot;
    if (u >= U7) break;
    int type, latent, b, qb = 0, h;
    if (u < U0) { type = 3; latent = 1; b = u >> 2; h = u & 3; }
    else if (u < U1) { const int v = u - U0; type = 1; latent = 1; b = v >> 5; qb = (v >> 2) & 7; h = v & 3; }
    else if (u < U2) { const int v = u - U1; type = 0; latent = 1; b = v >> 6; qb = (v >> 3) & 7; h = v & 7; }
    else if (u < U3) { const int v = u - U2; type = 2; latent = 1; b = v >> 6; qb = (v >> 3) & 7; h = v & 7; }
    else if (u < U4) { const int v = u - U3; type = 1; latent = 0; b = v >> 2; h = v & 3; }
    else if (u < U5) { const int v = u - U4; type = 0; latent = 0; b = v >> 3; h = v & 7; }
    else if (u < U6) { const int v = u - U5; type = 2; latent = 0; b = v >> 3; h = v & 7; }
    else { const int v = u - U6; type = 3; latent = 0; b = v >> 2; h = v & 3; }
    if (type == 0) mla_unit(P, latent != 0, b, qb, h, lds);
    else if (type == 1) diff_unit(P, l, latent != 0, b, qb, h, lds);
    else if (type == 2) gqa_unit(P, latent != 0, b, qb, h, lds);
    else ssm_unit(P, l, latent != 0, b, h, lds);
  }
}

__device__ void phase_glu(const Params& P, int l, LAS char* lds) {
  const half_t* Y = (const half_t*)(P.ws + WS_Y);
  const half_t* W = (const half_t*)(P.ws + WS_WGLU) + (size_t)l * 512 * 512;
  half_t* SG = (half_t*)(P.ws + WS_SG);
  const float* gb = P.in[I_GLUB] + l * 512;
  for (int u = blockIdx.x; u < 48 * 4; u += gridDim.x) {
    const int ct = u / 48, rt = u % 48;
    f32x4 acc[4][4]; zero_acc(acc);
    gemm_kloop(acc, Y + (size_t)rt * 256 * 512, 512, W + (size_t)ct * 128 * 512, 512, 512, lds);
    EPI_COORDS
#pragma unroll
    for (int m = 0; m < 4; ++m) {
      const int r = rt * 256 + wr * 64 + m * 16 + fr;
#pragma unroll
      for (int n = 0; n < 4; ++n) {
        const int c = ct * 128 + wc * 64 + n * 16 + fq * 4;
        const f32x4 y = to_f32x4(*(const half4*)(Y + (size_t)r * 512 + c));
        half_t* sp = SG + (size_t)r * SGW + 1536 + c;
        const f32x4 sg = to_f32x4(*(const half4*)sp);
        const f32x4 bb = *(const f32x4*)(gb + c);
        f32x4 o;
#pragma unroll
        for (int j = 0; j < 4; ++j) o[j] = y[j] * sigmoidf_(acc[m][n][j] + bb[j]) * sg[j];
        *(half4*)sp = to_half4(o);
      }
    }
  }
}

__device__ void phase_branch(const Params& P, int l, LAS char* lds) {
  const half_t* H = (const half_t*)(P.ws + WS_H);
  const half_t* WIN = (const half_t*)(P.ws + WS_WIN) + (size_t)l * NW1 * 1024;
  const half_t* WBR = (const half_t*)(P.ws + WS_WBR) + (size_t)l * 4 * 1024 * 512;
  const half_t* ABR = (const half_t*)(P.ws + WS_SG);
  half_t* MG = (half_t*)(P.ws + WS_P1);
  for (int u = blockIdx.x; u < 48 * 8; u += gridDim.x) {
    const int ct = u / 48, rt = u % 48;
    half2v mgh[4][4][2];
#pragma unroll
    for (int m = 0; m < 4; ++m)
#pragma unroll
      for (int q = 0; q < 4; ++q) { mgh[m][q][0] = (half2v){(half_t)0.f, (half_t)0.f}; mgh[m][q][1] = mgh[m][q][0]; }
    for (int n = 0; n < 4; ++n) {
      half2v gpk[4][4][2];
      {
        f32x4 acc[4][4]; zero_acc(acc);
        gemm_kloop(acc, H + (size_t)rt * 256 * 1024, 1024, WIN + (size_t)(5376 + n * 1024 + ct * 128) * 1024, 1024, 1024, lds);
#pragma unroll
        for (int m = 0; m < 4; ++m)
#pragma unroll
          for (int q = 0; q < 4; ++q) {
            gpk[m][q][0] = (half2v){(half_t)sigmoidf_(acc[m][q][0]), (half_t)sigmoidf_(acc[m][q][1])};
            gpk[m][q][1] = (half2v){(half_t)sigmoidf_(acc[m][q][2]), (half_t)sigmoidf_(acc[m][q][3])};
            __builtin_amdgcn_sched_barrier(0);
          }
      }
      f32x4 acc[4][4]; zero_acc(acc);
      gemm_kloop(acc, ABR + (size_t)rt * 256 * SGW + n * 512, SGW, WBR + (size_t)(n * 1024 + ct * 128) * 512, 512, 512, lds);
#pragma unroll
      for (int m = 0; m < 4; ++m)
#pragma unroll
        for (int q = 0; q < 4; ++q) {
          mgh[m][q][0] = (half2v){(half_t)((float)mgh[m][q][0][0] + (float)gpk[m][q][0][0] * acc[m][q][0]), (half_t)((float)mgh[m][q][0][1] + (float)gpk[m][q][0][1] * acc[m][q][1])};
          mgh[m][q][1] = (half2v){(half_t)((float)mgh[m][q][1][0] + (float)gpk[m][q][1][0] * acc[m][q][2]), (half_t)((float)mgh[m][q][1][1] + (float)gpk[m][q][1][1] * acc[m][q][3])};
          __builtin_amdgcn_sched_barrier(0);
        }
    }
    EPI_COORDS
#pragma unroll
    for (int m = 0; m < 4; ++m) {
      const int r = rt * 256 + wr * 64 + m * 16 + fr;
#pragma unroll
      for (int q = 0; q < 4; ++q) { half4 hv; hv[0] = mgh[m][q][0][0]; hv[1] = mgh[m][q][0][1]; hv[2] = mgh[m][q][1][0]; hv[3] = mgh[m][q][1][1];
        *(half4*)(MG + (size_t)r * 1024 + ct * 128 + wc * 64 + q * 16 + fq * 4) = hv; }
    }
  }
}

__device__ void phase_out(const Params& P, int l, LAS char* lds) {
  const half_t* MG = (const half_t*)(P.ws + WS_P1);
  const half_t* W = (const half_t*)(P.ws + WS_WOUT) + (size_t)l * 1024 * 1024;
  for (int u = blockIdx.x; u < 48 * 8; u += gridDim.x) {
    const int ct = u / 48, rt = u % 48;
    f32x4 acc[4][4]; zero_acc(acc);
    gemm_kloop(acc, MG + (size_t)rt * 256 * 1024, 1024, W + (size_t)ct * 128 * 1024, 1024, 1024, lds);
    EPI_COORDS
#pragma unroll
    for (int m = 0; m < 4; ++m) {
      const int r = rt * 256 + wr * 64 + m * 16 + fr;
      const float* xr = xin_row(P, l, r);
      const float* ga = (const float*)(P.ws + WS_MOD) + ((size_t)l * 3 + tok_modrow(r)) * 3072 + 2048;
#pragma unroll
      for (int n = 0; n < 4; ++n) {
        const int c = ct * 128 + wc * 64 + n * 16 + fq * 4;
        const f32x4 xv = *(const f32x4*)(xr + c), gv = *(const f32x4*)(ga + c);
        *(f32x4*)(P.out + (size_t)r * DM + c) = xv + gv * acc[m][n];
      }
    }
  }
}

constexpr int N_PHASES = 18;
__global__ void __launch_bounds__(NTHR, 2) fwd_kernel(Params P, int p_lo, int p_hi) {
  extern __shared__ __attribute__((aligned(16))) char smem_raw[];
  LAS char* lds = (LAS char*)smem_raw;
  for (int ph = p_lo; ph < p_hi; ++ph) {
    if (ph == 0) phase_prologue(P, lds);
    else if (ph == 17) phase_final(P);
    else {
      const int l = (ph - 1) >> 3, s = (ph - 1) & 7;
      switch (s) {
        case 0: phase_norm(P, l); break;
        case 1: phase_gemm1(P, l, lds); break;
        case 2: phase_post(P, l, lds); break;
        case 3: phase_gemm2(P, l, lds); break;
        case 4: phase_mix(P, l, lds); break;
        case 5: phase_glu(P, l, lds); break;
        case 6: phase_branch(P, l, lds); break;
        default: phase_out(P, l, lds); break;
      }
    }
#if ONE_LAUNCH
    if (ph + 1 < p_hi) cg::this_grid().sync();
#endif
  }
}

extern "C" void kernel_launch(void* const* d_in, const int* in_sizes, int n_in, void* d_out, int out_size, void* d_ws, size_t ws_size, hipStream_t stream) {
  static int grid = 0;
  if (grid == 0) {
    if (n_in != 39 || ws_size < WS_END) { fprintf(stderr, "kernel_launch: need 39 inputs and %zu bytes of workspace (got %d, %zu)\n", (size_t)WS_END, n_in, ws_size); grid = -1; return; }
    int dev = 0, cus = 0;
    hipGetDevice(&dev);
    hipDeviceGetAttribute(&cus, hipDeviceAttributeMultiprocessorCount, dev);
    hipFuncSetAttribute((const void*)fwd_kernel, hipFuncAttributeMaxDynamicSharedMemorySize, LDS_BYTES);
    int per_cu = 0;
    hipOccupancyMaxActiveBlocksPerMultiprocessor(&per_cu, (const void*)fwd_kernel, NTHR, LDS_BYTES);
    (void)hipGetLastError();
    if (per_cu < 1) { fprintf(stderr, "kernel_launch: occupancy query says %d blocks per CU\n", per_cu); grid = -1; return; }
    grid = cus;
  }
  if (grid < 0) return;
  Params p{};
  for (int i = 0; i < 39; ++i) p.in[i] = (const float*)d_in[i];
  p.out = (float*)d_out; p.ws = (char*)d_ws;
  hipMemsetAsync(d_ws, 0, 65536, stream);
#if ONE_LAUNCH
  int lo = 0, hi = N_PHASES;
  void* args[] = {&p, &lo, &hi};
  hipError_t e = hipLaunchCooperativeKernel((const void*)fwd_kernel, dim3(grid), dim3(NTHR), args, LDS_BYTES, stream);
  if (e != hipSuccess) fprintf(stderr, "cooperative launch failed: %s\n", hipGetErrorString(e));
#else
  for (int ph = 0; ph < N_PHASES; ++ph) fwd_kernel<<<dim3(grid), dim3(NTHR), LDS_BYTES, stream>>>(p, ph, ph + 1);
#endif
}
```

```cpp
#include <hip/hip_runtime.h>
#include <hip/hip_cooperative_groups.h>
#include <cstdint>
#include <cstdio>
#include <utility>
namespace cg = cooperative_groups;
template <class F, int... I> __device__ __forceinline__ void static_for_(F&& f, std::integer_sequence<int, I...>) { (f(std::integral_constant<int, I>{}), ...); }
template <int N, class F> __device__ __forceinline__ void static_for(F&& f) { static_for_(f, std::make_integer_sequence<int, N>{}); }

#ifndef ONE_LAUNCH
#define ONE_LAUNCH 1
#endif

#define LAS __attribute__((address_space(3)))
typedef _Float16 half_t;
typedef _Float16 half8 __attribute__((ext_vector_type(8)));
typedef _Float16 half4 __attribute__((ext_vector_type(4)));
typedef _Float16 half2v __attribute__((ext_vector_type(2)));
typedef float f32x4 __attribute__((ext_vector_type(4)));
typedef float f32x16 __attribute__((ext_vector_type(16)));
typedef short v4i16_t __attribute__((ext_vector_type(4)));
typedef unsigned u32x2 __attribute__((ext_vector_type(2)));

constexpr int DM = 1024, NPT = 8192, NLT = 4096, NTOK = NPT + NLT, NKEY = 8192 + 2 * 2560;
constexpr int LSEQ = 2048, PSEQ = 256, LKEYS = 2560, PAST = 512;
constexpr int D_IN = 9376, NW1 = 9472;
constexpr int P1COLS = 3328;
constexpr int P1W = 3392;
constexpr int SGW = 2112, HP = 1088, KVP = 1088, YP = 576, MGP = 1088, QAP = 832;
constexpr int WINP = 1088, WOUTP = 1088, WBRP = 576, WGLUP = 576, WQBP = 320, WKVBP = 320;
constexpr float EPS = 1e-6f;
constexpr float LOG2E = 1.4426950408889634f;
constexpr int C_QA = 0, C_KVA = 256, C_KPE = 384, C_DQ = 512, C_DK = 1024, C_DV = 1536, C_GQ = 2048, C_GK = 2560, C_GV = 2688, C_U = 2816;
constexpr size_t O_Y = 0, O_CKV = 12582912, O_KROPE = 14680064, O_DK = 15204352, O_DV = 23592960, O_GK = 31981568, O_GV = 34078720, O_ST = 36175872;

constexpr size_t al256(size_t x) { return (x + 255) & ~(size_t)255; }
constexpr size_t WS_CTRL = 0;
constexpr size_t WS_MOD = 65536;
constexpr size_t WS_LAM = WS_MOD + al256(2 * 3 * 3072 * 4);
constexpr size_t WS_ROPE64 = WS_LAM + 256;
constexpr size_t WS_ROPE32 = WS_ROPE64 + 2048 * 32 * 2 * 4;
constexpr size_t WS_ABAR = WS_ROPE32 + 2048 * 16 * 2 * 4;
constexpr size_t WS_BM = WS_ABAR + 128 * 64 * 2 * 4;
constexpr size_t WS_BSC = WS_BM + 128 * 128 * 16 * 2;
constexpr size_t WS_CM = WS_BSC + 512;
constexpr size_t WS_WIN = WS_CM + 128 * 16 * 128 * 2;
constexpr size_t WS_WQB = WS_WIN + (size_t)2 * NW1 * WINP * 2;
constexpr size_t WS_WKVB = WS_WQB + (size_t)2 * 768 * WQBP * 2;
constexpr size_t WS_WGLU = WS_WKVB + (size_t)2 * 1024 * WKVBP * 2;
constexpr size_t WS_WBR = WS_WGLU + (size_t)2 * 512 * WGLUP * 2;
constexpr size_t WS_WOUT = WS_WBR + (size_t)2 * 4 * 1024 * WBRP * 2;
constexpr size_t WS_H = WS_WOUT + (size_t)2 * 1024 * WOUTP * 2;
constexpr size_t WS_SG = WS_H + (size_t)NTOK * HP * 2;
constexpr size_t WS_P1 = WS_SG + (size_t)NTOK * SGW * 2;
constexpr size_t WS_QA = WS_P1 + (size_t)NKEY * P1W * 2;
constexpr size_t WS_KVA = WS_QA + (size_t)NTOK * QAP * 2;
constexpr size_t WS_Y = WS_KVA + (size_t)NKEY * KVP * 2;
constexpr size_t WS_HEND = WS_Y + (size_t)NTOK * YP * 2;
constexpr size_t WS_A256 = WS_HEND + (size_t)16 * 64 * 64 * 2 * 4;
constexpr size_t WS_END = WS_A256 + (size_t)128 * 64 * 2 * 4;
constexpr int BROP = 4160;
constexpr size_t WS_BRO = WS_P1;
constexpr size_t WS_MG = WS_BRO + (size_t)NTOK * BROP * 2;
static_assert(WS_MG + (size_t)NTOK * MGP * 2 <= WS_Y, "BRO + MG must fit in the dead P1|QA|KVA region");

constexpr int LDS_BYTES = 147456;
constexpr int NTHR = 512;

struct Params {
  const float* in[39];
  float* out;
  char* ws;
};
enum { I_XP = 0, I_XS, I_CCKV, I_CKROPE, I_CDK, I_CDV, I_CGK, I_CGV, I_STATE, I_C, I_CCTX, I_NORMG, I_WMOD, I_BMOD, I_WIN, I_QNORM, I_WQB, I_KVNORM, I_WKVB,
       I_LQ1, I_LK1, I_LQ2, I_LK2, I_SUBLN, I_GQN, I_GKN, I_ARE, I_AIM, I_LOGDT, I_BRE, I_BIM, I_CRE, I_CIM, I_SSMD, I_GLUW, I_GLUB, I_WBR, I_WOUT, I_FNORM };

__device__ __forceinline__ float wave_sum(float v) {
#pragma unroll
  for (int o = 1; o < 64; o <<= 1) v += __shfl_xor(v, o);
  return v;
}
__device__ __forceinline__ float sigmoidf_(float x) { return __builtin_amdgcn_rcpf(1.0f + __builtin_amdgcn_exp2f(-1.4426950408889634f * x)); }
__device__ __forceinline__ float siluf_(float x) { return x * __builtin_amdgcn_rcpf(1.0f + __builtin_amdgcn_exp2f(-1.4426950408889634f * x)); }
__device__ __forceinline__ float gelu_tanh(float x) {
  const float z = 0.7978845608028654f * (x + 0.044715f * x * x * x);
  const float e = __expf(2.0f * z);
  const float th = 1.0f - 2.0f / (e + 1.0f);
  return 0.5f * x * (1.0f + th);
}
__device__ __forceinline__ half4 to_half4(f32x4 v) { half4 h; h[0] = (half_t)v[0]; h[1] = (half_t)v[1]; h[2] = (half_t)v[2]; h[3] = (half_t)v[3]; return h; }
__device__ __forceinline__ f32x4 to_f32x4(half4 h) { f32x4 v; v[0] = (float)h[0]; v[1] = (float)h[1]; v[2] = (float)h[2]; v[3] = (float)h[3]; return v; }
__device__ __forceinline__ int tile_keyrow(int rt) {
  if (rt < 32) return rt * 256;
  const int j = rt - 32; return 8192 + (j >> 3) * LKEYS + PAST + (j & 7) * 256;
}
__device__ __forceinline__ int tok_keyrow(int t) {
  if (t < NPT) return t;
  const int j = t - NPT; return 8192 + (j >> 11) * LKEYS + PAST + (j & 2047);
}
__device__ __forceinline__ int tok_modrow(int t) { return t < NPT ? 0 : 1 + ((t - NPT) >> 11); }
__device__ __forceinline__ float swap_add(float v) {
  auto rr = __builtin_amdgcn_permlane32_swap(__float_as_uint(v), __float_as_uint(v), false, false);
  return __uint_as_float(rr[0]) + __uint_as_float(rr[1]);
}
__device__ __forceinline__ float swap_max(float v) {
  auto rr = __builtin_amdgcn_permlane32_swap(__float_as_uint(v), __float_as_uint(v), false, false);
  return fmaxf(__uint_as_float(rr[0]), __uint_as_float(rr[1]));
}

__device__ __forceinline__ int lds_byte(int r, int c) { const int st = (r >> 4) * 2 + (c >> 5), rr = r & 15, cc = c & 31, ob = rr * 64 + cc * 2; return st * 1024 + (ob ^ (((ob >> 9) & 1) << 5)); }
__device__ __forceinline__ void stage_rc(int b, int& R, int& C) { const int st = b / 1024, sb = b % 1024, swz = sb ^ (((sb >> 9) & 1) << 5); R = (st >> 1) * 16 + swz / 64; C = (st & 1) * 32 + (swz % 64) / 2; }
constexpr int HTB = 16384, GSTAGE = 3 * HTB;
#define WAIT_V(n) asm volatile("s_waitcnt vmcnt(" #n ")" ::: "memory")
#define WAIT_L0() asm volatile("s_waitcnt lgkmcnt(0)" ::: "memory")
#define BAR() __builtin_amdgcn_s_barrier()

__device__ __forceinline__ void glds16(const half_t* src, LAS char* dst) {
  __builtin_amdgcn_global_load_lds((const unsigned*)src, (LAS unsigned*)dst, 16, 0, 0);
}

__device__ __forceinline__ int ltid() { int t = threadIdx.x; asm volatile("" : "+v"(t)); return t; }
__device__ __forceinline__ void gemm_kloop(f32x4 (&acc)[4][4], const half_t* __restrict__ A, int lda, const half_t* __restrict__ Bt, int ldb, int K, LAS char* lds) {
  const int tid = ltid(), lane = tid & 63, wid = tid >> 6, wr = wid >> 1, wc = wid & 1, fr = lane & 15, fq = lane >> 4;
  int R0, C0, R1, C1;
  stage_rc(tid * 16, R0, C0); stage_rc(tid * 16 + 8192, R1, C1);
  const unsigned oa0 = (unsigned)(R0 * lda + C0) * 2u, oa1 = (unsigned)(R1 * lda + C1) * 2u;
  const unsigned ob0 = (unsigned)(R0 * ldb + C0) * 2u, ob1 = (unsigned)(R1 * ldb + C1) * 2u;
  const char* Ab = (const char*)A; const char* Ab1 = Ab + (size_t)128 * lda * 2; const char* Bb = (const char*)Bt;
  LAS char* d0 = lds + tid * 16;
  const int nt = K >> 6;
  const int aoff0 = (wr >> 1) * HTB + lds_byte((wr & 1) * 64 + fr, fq * 8), boff0 = 2 * HTB + lds_byte(wc * 64 + fr, fq * 8);
#define GSTG(kt, buf) do { LAS char* d_ = d0 + (buf) * GSTAGE; const size_t ko_ = (size_t)(kt) * 128; \
    glds16((const half_t*)(Ab + ko_ + oa0), d_); glds16((const half_t*)(Ab + ko_ + oa1), d_ + 8192); \
    glds16((const half_t*)(Ab1 + ko_ + oa0), d_ + HTB); glds16((const half_t*)(Ab1 + ko_ + oa1), d_ + HTB + 8192); \
    glds16((const half_t*)(Bb + ko_ + ob0), d_ + 2 * HTB); glds16((const half_t*)(Bb + ko_ + ob1), d_ + 2 * HTB + 8192); } while (0)
  GSTG(0, 0);
  for (int t = 0; t < nt; ++t) {
    if (t + 1 < nt) { GSTG(t + 1, (t + 1) & 1); WAIT_V(6); } else { WAIT_V(0); }
    BAR();
    LAS char* base = lds + (t & 1) * GSTAGE;
#pragma unroll
    for (int kk = 0; kk < 2; ++kk) {
      half8 a[4], b[4];
#pragma unroll
      for (int m = 0; m < 4; ++m) { a[m] = *(LAS half8*)(base + aoff0 + m * 2048 + kk * 1024); b[m] = *(LAS half8*)(base + boff0 + m * 2048 + kk * 1024); }
#pragma unroll
      for (int m = 0; m < 4; ++m)
#pragma unroll
        for (int n = 0; n < 4; ++n) acc[m][n] = __builtin_amdgcn_mfma_f32_16x16x32_f16(b[n], a[m], acc[m][n], 0, 0, 0);
    }
    WAIT_L0(); BAR();
  }
#undef GSTG
}
__device__ __forceinline__ void zero_acc(f32x4 (&acc)[4][4]) {
#pragma unroll
  for (int m = 0; m < 4; ++m)
#pragma unroll
    for (int n = 0; n < 4; ++n) acc[m][n] = (f32x4){0.f, 0.f, 0.f, 0.f};
}
#define EPI_COORDS const int tid = ltid(), lane = tid & 63, wid = tid >> 6, wr = wid >> 1, wc = wid & 1, fr = lane & 15, fq = lane >> 4; (void)wr; (void)wc; (void)fr; (void)fq;


constexpr int STG_ROWB = 272;
__device__ __forceinline__ void stage_tile(const f32x4 (&v)[4][4], LAS char* lds) {
  EPI_COORDS
#pragma unroll
  for (int m = 0; m < 4; ++m)
#pragma unroll
    for (int n = 0; n < 4; ++n) *(LAS half4*)(lds + (wr * 64 + m * 16 + fr) * STG_ROWB + (wc * 64 + n * 16 + fq * 4) * 2) = to_half4(v[m][n]);
}
template <class F> __device__ __forceinline__ void drain_tile(LAS char* lds, F f) {
  const int tid = ltid();
  __syncthreads();
#pragma unroll
  for (int i = 0; i < 8; ++i) {
    const int idx = i * 512 + tid, row = idx >> 4, ch = idx & 15;
    const half8 v = *(LAS half8*)(lds + row * STG_ROWB + ch * 16);
    f(row, ch * 8, v);
  }
  __syncthreads();
}


__device__ __forceinline__ int fl_byte(int r, int c) { return (r >> 3) * 1024 + (r & 7) * 128 + ((((c >> 3) ^ (r & 7)) & 7) << 4) + (c & 7) * 2; }
__device__ __forceinline__ void fl_stage_rc(int b, int& R, int& C) { const int st = b >> 10, row = (b >> 7) & 7, ch = (b >> 4) & 7; R = st * 8 + row; C = ((ch ^ row) & 7) * 8; }
__device__ __forceinline__ void gemm256_kloop(f32x4 (&acc)[2][2][4][2], const half_t* __restrict__ A, int lda, const half_t* __restrict__ Bt, int ldb, int K, LAS char* lds,
                                              int bgap = 0, int bhalf = 128, int abl = 0) {
  const int tid = ltid(), lane = tid & 63, wid = tid >> 6, wr = wid >> 2, wc = wid & 3, fr = lane & 15, fq = lane >> 4;
  int R0, C0, R1, C1;
  fl_stage_rc(tid * 16, R0, C0); fl_stage_rc(tid * 16 + 8192, R1, C1);
  const unsigned oa0 = (unsigned)(R0 * lda + C0) * 2u, oa1 = (unsigned)(R1 * lda + C1) * 2u;
  const unsigned ob0 = (unsigned)((R0 + (R0 >> 6) * bgap) * ldb + C0) * 2u, ob1 = (unsigned)((R1 + (R1 >> 6) * bgap) * ldb + C1) * 2u;
  const char* Ab0 = (const char*)A; const char* Ab1 = Ab0 + (size_t)128 * lda * 2;
  const char* Bb0 = (const char*)Bt; const char* Bb1 = Bb0 + (size_t)bhalf * ldb * 2;
  LAS char* d0 = lds + tid * 16;
  const int nt = K >> 6;
  const int aoff = fl_byte(wr * 64 + fr, fq * 8), boff = fl_byte(wc * 32 + fr, fq * 8);
#define G_SA(b, h) (((b) * 2 + (h)) * HTB)
#define G_SB(b, h) ((4 + (b) * 2 + (h)) * HTB)
#define G_STAGE_A(b, h, kt) do { if (abl & 4) break; const char* s_ = ((h) ? Ab1 : Ab0) + (size_t)(kt) * 128; LAS char* d_ = d0 + G_SA(b, h); glds16((const half_t*)(s_ + oa0), d_); glds16((const half_t*)(s_ + oa1), d_ + 8192); } while (0)
#define G_STAGE_B(b, h, kt) do { if (abl & 4) break; const char* s_ = ((h) ? Bb1 : Bb0) + (size_t)(kt) * 128; LAS char* d_ = d0 + G_SB(b, h); glds16((const half_t*)(s_ + ob0), d_); glds16((const half_t*)(s_ + ob1), d_ + 8192); } while (0)
#define G_LDA(dst, b, h) do { if (abl & 2) break; _Pragma("unroll") for (int m = 0; m < 4; ++m) _Pragma("unroll") for (int k = 0; k < 2; ++k) dst[m][k] = *(LAS half8*)(lds + G_SA(b, h) + ((aoff + m * 2048) ^ (k * 64))); } while (0)
#define G_LDB(dst, b, h) do { if (abl & 2) break; _Pragma("unroll") for (int n = 0; n < 2; ++n) _Pragma("unroll") for (int k = 0; k < 2; ++k) dst[n][k] = *(LAS half8*)(lds + G_SB(b, h) + ((boff + n * 2048) ^ (k * 64))); } while (0)
#define G_MMA(ai, bj, At_, Bt_) do { if (abl & 1) break; __builtin_amdgcn_s_setprio(1); _Pragma("unroll") for (int m = 0; m < 4; ++m) _Pragma("unroll") for (int n = 0; n < 2; ++n) _Pragma("unroll") for (int k = 0; k < 2; ++k) \
    acc[ai][bj][m][n] = __builtin_amdgcn_mfma_f32_16x16x32_f16(Bt_[n][k], At_[m][k], acc[ai][bj][m][n], 0, 0, 0); __builtin_amdgcn_s_setprio(0); } while (0)
#define G_WAIT_L(n) asm volatile("s_waitcnt lgkmcnt(" #n ")" ::: "memory")
#define G_SCHED __builtin_amdgcn_sched_barrier(0)
  half8 At[4][2], B0[2][2], B1[2][2];
  G_STAGE_B(0, 0, 0); G_STAGE_B(0, 1, 0); G_STAGE_A(0, 0, 0); G_STAGE_A(0, 1, 0);
  if (wr == 1) BAR();
  WAIT_V(2); BAR();
  G_STAGE_B(1, 0, 1); G_STAGE_A(1, 0, 1); G_STAGE_B(1, 1, 1);
  WAIT_V(6); BAR();
  asm volatile(".p2align 8" ::: "memory");
  for (int t = 0; t < nt; t += 2) {
    const bool last = (t == nt - 2);
    const int t2 = last ? 0 : t + 2, t3 = t2 + 1;
    G_LDB(B0, 0, 0); G_LDB(B1, 0, 1); G_SCHED; G_LDA(At, 0, 0); G_STAGE_A(1, 1, t + 1);
    WAIT_V(8); G_WAIT_L(0); BAR(); G_MMA(0, 0, At, B0); G_MMA(0, 1, At, B1); BAR(); G_SCHED;
    G_LDA(At, 0, 1); G_STAGE_B(0, 0, t2); G_STAGE_B(0, 1, t2); G_STAGE_A(0, 0, t2);
    WAIT_V(8); G_WAIT_L(0); BAR(); G_MMA(1, 0, At, B0); G_MMA(1, 1, At, B1); BAR(); G_SCHED;
    G_LDB(B0, 1, 0); G_LDB(B1, 1, 1); G_SCHED; G_LDA(At, 1, 0); G_STAGE_A(0, 1, t2);
    WAIT_V(8); G_WAIT_L(0); BAR(); G_MMA(0, 0, At, B0); G_MMA(0, 1, At, B1); BAR(); G_SCHED;
    G_LDA(At, 1, 1); G_STAGE_B(1, 0, t3); G_STAGE_B(1, 1, t3); G_STAGE_A(1, 0, t3);
    WAIT_V(8); G_WAIT_L(0); BAR(); G_MMA(1, 0, At, B0); G_MMA(1, 1, At, B1); BAR(); G_SCHED;
  }
  WAIT_V(0);
  if (wr == 0) BAR();
  BAR();
#undef G_SA
#undef G_SB
#undef G_STAGE_A
#undef G_STAGE_B
#undef G_LDA
#undef G_LDB
#undef G_MMA
#undef G_WAIT_L
#undef G_SCHED
}
__device__ __forceinline__ void zero_acc256(f32x4 (&acc)[2][2][4][2]) {
#pragma unroll
  for (int a = 0; a < 2; ++a)
#pragma unroll
    for (int b = 0; b < 2; ++b)
#pragma unroll
      for (int m = 0; m < 4; ++m)
#pragma unroll
        for (int n = 0; n < 2; ++n) acc[a][b][m][n] = (f32x4){0.f, 0.f, 0.f, 0.f};
}
constexpr int TSTR = 528;
__device__ __forceinline__ void stage_full256(const f32x4 (&acc)[2][2][4][2], LAS char* lds) {
  const int tid = ltid(), lane = tid & 63, wid = tid >> 6, wr = wid >> 2, wc = wid & 3, fr = lane & 15, fq = lane >> 4;
#pragma unroll
  for (int ai = 0; ai < 2; ++ai)
#pragma unroll
    for (int bj = 0; bj < 2; ++bj)
#pragma unroll
      for (int m = 0; m < 4; ++m)
#pragma unroll
        for (int n = 0; n < 2; ++n)
          *(LAS half4*)(lds + (ai * 128 + wr * 64 + m * 16 + fr) * TSTR + (bj * 128 + wc * 32 + n * 16 + fq * 4) * 2) = to_half4(acc[ai][bj][m][n]);
}
template <class F> __device__ __forceinline__ void drain_full256(LAS char* lds, F f) {
  const int tid = ltid();
  __syncthreads();
#pragma unroll
  for (int i = 0; i < 16; ++i) {
    const int idx = i * 512 + tid, row = idx >> 5, ch = idx & 31;
    const half8 v = *(LAS half8*)(lds + row * TSTR + ch * 16);
    f(row, ch * 8, v);
  }
  __syncthreads();
}
__device__ __forceinline__ void stage_half256(const f32x4 (&acc)[2][2][4][2], int bj, LAS char* lds) {
  const int tid = ltid(), lane = tid & 63, wid = tid >> 6, wr = wid >> 2, wc = wid & 3, fr = lane & 15, fq = lane >> 4;
#pragma unroll
  for (int ai = 0; ai < 2; ++ai)
#pragma unroll
    for (int m = 0; m < 4; ++m)
#pragma unroll
      for (int n = 0; n < 2; ++n)
        *(LAS half4*)(lds + (ai * 128 + wr * 64 + m * 16 + fr) * STG_ROWB + (wc * 32 + n * 16 + fq * 4) * 2) = to_half4(bj ? acc[ai][1][m][n] : acc[ai][0][m][n]);
}

__device__ __forceinline__ void transpose_tile(const float* __restrict__ src, int lds_src, int Ksrc, half_t* __restrict__ dst, int dpitch, int n0, int k0, int colshift_mode, LAS char* wlds) {
  LAS float* tile = (LAS float*)wlds;
  const int lane = ltid() & 63;
  const int c4 = (lane & 15) * 4, kr = lane >> 4;
  const int n = n0 + c4;
  int col = n; bool cvalid = true;
  if (colshift_mode == 1) { if (n >= 416 && n < 512) cvalid = false; else if (n >= 512) col = n - 96; }
  f32x4 v[16];
#pragma unroll
  for (int i = 0; i < 16; ++i) {
    const int kk = kr + i * 4;
    v[i] = (f32x4){0.f, 0.f, 0.f, 0.f};
    if (cvalid && (k0 + kk) < Ksrc) v[i] = *(const f32x4*)(src + (size_t)(k0 + kk) * lds_src + col);
  }
#pragma unroll
  for (int i = 0; i < 16; ++i) {
    const int kk = kr + i * 4;
    tile[kk * 65 + c4 + 0] = v[i][0]; tile[kk * 65 + c4 + 1] = v[i][1]; tile[kk * 65 + c4 + 2] = v[i][2]; tile[kk * 65 + c4 + 3] = v[i][3];
  }
  __builtin_amdgcn_fence(__ATOMIC_RELEASE, "wavefront"); __builtin_amdgcn_wave_barrier(); __builtin_amdgcn_fence(__ATOMIC_ACQUIRE, "wavefront");
  const int kc = (lane & 7) * 8;
#pragma unroll
  for (int i = 0; i < 8; ++i) {
    const int nn = (lane >> 3) + i * 8;
    half8 h;
#pragma unroll
    for (int j = 0; j < 8; ++j) h[j] = (half_t)tile[(kc + j) * 65 + nn];
    *(half8*)(dst + (size_t)(n0 + nn) * dpitch + k0 + kc) = h;
  }
  __builtin_amdgcn_fence(__ATOMIC_RELEASE, "wavefront"); __builtin_amdgcn_wave_barrier(); __builtin_amdgcn_fence(__ATOMIC_ACQUIRE, "wavefront");
}

__device__ void phase_prologue(const Params& P, LAS char* lds, int what = 3) {
  const int tid = ltid();
  char* ws = P.ws;
  constexpr int T_WIN = (NW1 / 64) * 16, T_WQB = 12 * 4, T_WKVB = 16 * 4, T_WGLU = 8 * 8, T_WBR = 4 * 16 * 8, T_WOUT = 16 * 16;
  constexpr int T_LAYER = T_WIN + T_WQB + T_WKVB + T_WGLU + T_WBR + T_WOUT;
  constexpr int U_TR = 2 * T_LAYER, U_MOD = 192, U_SSM = 16, U_ROPE = 192;
  constexpr int U_ALL = U_TR + U_MOD + U_SSM + U_ROPE;
  const int nbw = (int)gridDim.x - 16;
  if (what & 1)
  for (int u = (blockIdx.x < 16) ? (U_MOD + (int)blockIdx.x) : ((int)blockIdx.x - 16); u < U_MOD + U_SSM + U_ROPE; u += nbw) {
    int v = u;
    if (blockIdx.x >= 16 && v >= U_MOD) v += U_SSM;
    if (v >= U_MOD + U_SSM + U_ROPE) break;
    if (v < U_MOD) {
      const int l = v / 96, n0 = (v % 96) * 32;
      const int nn = tid & 31, ks = tid >> 5;
      const float* w = P.in[I_WMOD] + (size_t)l * 1024 * 3072 + n0 + nn;
      float s0 = 0.f, s1 = 0.f, s2 = 0.f;
      for (int k = ks * 64; k < ks * 64 + 64; ++k) {
        const float wv = w[(size_t)k * 3072];
        s0 += siluf_(P.in[I_CCTX][k]) * wv; s1 += siluf_(P.in[I_C][k]) * wv; s2 += siluf_(P.in[I_C][1024 + k]) * wv;
      }
      LAS float* red = (LAS float*)lds;
      red[(0 * 16 + ks) * 32 + nn] = s0; red[(1 * 16 + ks) * 32 + nn] = s1; red[(2 * 16 + ks) * 32 + nn] = s2;
      __syncthreads();
      if (tid < 96) {
        const int r = tid >> 5, n = tid & 31; float s = 0.f;
        for (int k = 0; k < 16; ++k) s += red[(r * 16 + k) * 32 + n];
        ((float*)(ws + WS_MOD))[((size_t)l * 3 + r) * 3072 + n0 + n] = s + P.in[I_BMOD][(size_t)l * 3072 + n0 + n];
      }
      __syncthreads();
      continue;
    }
    v -= U_MOD;
    if (v < U_SSM) {
      const int e = v * 512 + tid;
      const int p = e & 63, idx = e >> 6;
      const double are = P.in[I_ARE][e], aim = P.in[I_AIM][e];
      const double dt = exp((double)P.in[I_LOGDT][idx]);
      const double mag = exp(are * dt), ang = aim * dt;
      const double abr = mag * cos(ang), abi = mag * sin(ang);
      const double nr = abr - 1.0, ni = abi, den = are * are + aim * aim;
      const double cr = (nr * are + ni * aim) / den, ci = (ni * are - nr * aim) / den;
      float* ab = (float*)(ws + WS_ABAR); ab[e * 2] = (float)abr; ab[e * 2 + 1] = (float)abi;
      { const double m256 = exp(256.0 * are * dt), a256 = 256.0 * ang; float* a2 = (float*)(ws + WS_A256); a2[e * 2] = (float)(m256 * cos(a256)); a2[e * 2 + 1] = (float)(m256 * sin(a256)); }
      const float sc = exp2f(ceilf(-log2f((float)dt)));
      if (p == 0) ((float*)(ws + WS_BSC))[idx] = 1.0f / sc;
      half_t* bm = (half_t*)(ws + WS_BM) + (size_t)idx * 2048;
      half_t* cm = (half_t*)(ws + WS_CM) + (size_t)idx * 2048;
      f32x4 brv[4], biv[4]; float crv[16], civ[16];
#pragma unroll
      for (int q = 0; q < 4; ++q) { brv[q] = *(const f32x4*)(P.in[I_BRE] + (size_t)e * 16 + q * 4); biv[q] = *(const f32x4*)(P.in[I_BIM] + (size_t)e * 16 + q * 4); }
#pragma unroll
      for (int n = 0; n < 16; ++n) { crv[n] = P.in[I_CRE][((size_t)idx * 16 + n) * 64 + p]; civ[n] = P.in[I_CIM][((size_t)idx * 16 + n) * 64 + p]; }
      half8 b0[2], b1[2];
#pragma unroll
      for (int n = 0; n < 16; ++n) {
        const double br = brv[n >> 2][n & 3], bi = biv[n >> 2][n & 3];
        b0[n >> 3][n & 7] = (half_t)(float)((cr * br - ci * bi) * sc);
        b1[n >> 3][n & 7] = (half_t)(float)((cr * bi + ci * br) * sc);
        cm[n * 128 + 2 * p] = (half_t)crv[n];
        cm[n * 128 + 2 * p + 1] = (half_t)(-civ[n]);
      }
      *(half8*)(bm + (2 * p) * 16) = b0[0]; *(half8*)(bm + (2 * p) * 16 + 8) = b0[1];
      *(half8*)(bm + (2 * p + 1) * 16) = b1[0]; *(half8*)(bm + (2 * p + 1) * 16 + 8) = b1[1];
      if (v == 0 && tid < 2) {
        const int l = tid; float a = 0.f, b = 0.f;
        for (int i = 0; i < 64; ++i) { a += P.in[I_LQ1][l * 64 + i] * P.in[I_LK1][l * 64 + i]; b += P.in[I_LQ2][l * 64 + i] * P.in[I_LK2][l * 64 + i]; }
        const float lam_init = 0.8f - 0.6f * expf(-0.3f * (float)l);
        ((float*)(ws + WS_LAM))[l] = expf(a) - expf(b) + lam_init;
      }
      continue;
    }
    v -= U_SSM;
    {
      const int e = v * 512 + tid;
      const int s = e / 48, j = e % 48;
      const float row = (float)(s >> 6), col = (float)(s & 63);
      if (j < 32) {
        const int q = j & 15; const float inv = powf(10000.0f, -(float)q / 16.0f);
        const float ang = (j < 16 ? row : col) * inv; float sn, cs; sincosf(ang, &sn, &cs);
        float* t = (float*)(ws + WS_ROPE64) + ((size_t)s * 32 + j) * 2; t[0] = cs; t[1] = sn;
      } else {
        const int jj = j - 32, q = jj & 7; const float inv = powf(10000.0f, -(float)q / 8.0f);
        const float ang = (jj < 8 ? row : col) * inv; float sn, cs; sincosf(ang, &sn, &cs);
        float* t = (float*)(ws + WS_ROPE32) + ((size_t)s * 16 + jj) * 2; t[0] = cs; t[1] = sn;
      }
    }
  }
  __syncthreads();
  if (blockIdx.x >= 16 && (what & 2)) {
    LAS char* wl = lds + (tid >> 6) * (64 * 65 * 4);
    for (int u = (tid >> 6) * nbw + ((int)blockIdx.x - 16); u < U_TR; u += 8 * nbw) {
      const int l = u / T_LAYER; int r = u % T_LAYER;
      if (r < T_WIN) { transpose_tile(P.in[I_WIN] + (size_t)l * 1024 * D_IN, D_IN, 1024, (half_t*)(ws + WS_WIN) + (size_t)l * NW1 * WINP, WINP, (r >> 4) * 64, (r & 15) * 64, 1, wl); continue; }
      r -= T_WIN;
      if (r < T_WQB) { transpose_tile(P.in[I_WQB] + (size_t)l * 256 * 768, 768, 256, (half_t*)(ws + WS_WQB) + (size_t)l * 768 * WQBP, WQBP, (r >> 2) * 64, (r & 3) * 64, 0, wl); continue; }
      r -= T_WQB;
      if (r < T_WKVB) { transpose_tile(P.in[I_WKVB] + (size_t)l * 128 * 1024, 1024, 128, (half_t*)(ws + WS_WKVB) + (size_t)l * 1024 * WKVBP, WKVBP, (r >> 2) * 64, (r & 3) * 64, 0, wl); continue; }
      r -= T_WKVB;
      if (r < T_WGLU) { transpose_tile(P.in[I_GLUW] + (size_t)l * 512 * 512, 512, 512, (half_t*)(ws + WS_WGLU) + (size_t)l * 512 * WGLUP, WGLUP, (r >> 3) * 64, (r & 7) * 64, 0, wl); continue; }
      r -= T_WGLU;
      if (r < T_WBR) { const int n = r / 128, rr = r % 128;
        transpose_tile(P.in[I_WBR] + ((size_t)l * 4 + n) * 512 * 1024, 1024, 512, (half_t*)(ws + WS_WBR) + ((size_t)l * 4 + n) * 1024 * WBRP, WBRP, (rr >> 3) * 64, (rr & 7) * 64, 0, wl); continue; }
      r -= T_WBR;
      transpose_tile(P.in[I_WOUT] + (size_t)l * 1024 * 1024, 1024, 1024, (half_t*)(ws + WS_WOUT) + (size_t)l * 1024 * WOUTP, WOUTP, (r >> 4) * 64, (r & 15) * 64, 0, wl);
    }
  }
}

__device__ __forceinline__ const float* xin_row(const Params& P, int l, int row) {
  if (l == 0) return row < NPT ? P.in[I_XP] + (size_t)row * DM : P.in[I_XS] + (size_t)(row - NPT) * DM;
  return P.out + (size_t)row * DM;
}
__device__ void phase_norm(const Params& P, int l) {
  const int tid_ = ltid(), lane = tid_ & 63, wid = tid_ >> 6;
  const float* g = P.in[I_NORMG] + l * DM;
  for (int row = blockIdx.x * 8 + wid; row < NTOK; row += gridDim.x * 8) {
    const float* x = xin_row(P, l, row);
    const float* mod = (const float*)(P.ws + WS_MOD) + ((size_t)l * 3 + tok_modrow(row)) * 3072;
    f32x4 v[4]; float ss = 0.f;
#pragma unroll
    for (int i = 0; i < 4; ++i) { v[i] = *(const f32x4*)(x + i * 256 + lane * 4); ss += v[i][0] * v[i][0] + v[i][1] * v[i][1] + v[i][2] * v[i][2] + v[i][3] * v[i][3]; }
    ss = wave_sum(ss);
    const float rstd = rsqrtf(ss * (1.0f / DM) + EPS);
    half_t* h = (half_t*)(P.ws + WS_H) + (size_t)row * HP;
#pragma unroll
    for (int i = 0; i < 4; ++i) {
      const int c = i * 256 + lane * 4;
      const f32x4 gg = *(const f32x4*)(g + c), sh = *(const f32x4*)(mod + c), sc = *(const f32x4*)(mod + 1024 + c);
      f32x4 o;
#pragma unroll
      for (int j = 0; j < 4; ++j) o[j] = v[i][j] * rstd * gg[j] * (1.0f + sc[j]) + sh[j];
      *(half4*)(h + c) = to_half4(o);
    }
  }
}
__device__ void phase_final(const Params& P) {
  const int tid_ = ltid(), lane = tid_ & 63, wid = tid_ >> 6;
  const float* g = P.in[I_FNORM];
  for (int row = blockIdx.x * 8 + wid; row < NTOK; row += gridDim.x * 8) {
    float* x = P.out + (size_t)row * DM;
    f32x4 v[4]; float ss = 0.f;
#pragma unroll
    for (int i = 0; i < 4; ++i) { v[i] = *(const f32x4*)(x + i * 256 + lane * 4); ss += v[i][0] * v[i][0] + v[i][1] * v[i][1] + v[i][2] * v[i][2] + v[i][3] * v[i][3]; }
    ss = wave_sum(ss);
    const float rstd = rsqrtf(ss * (1.0f / DM) + EPS);
#pragma unroll
    for (int i = 0; i < 4; ++i) {
      const int c = i * 256 + lane * 4;
      const f32x4 gg = *(const f32x4*)(g + c);
      f32x4 o;
#pragma unroll
      for (int j = 0; j < 4; ++j) o[j] = v[i][j] * rstd * gg[j];
      *(f32x4*)(x + c) = o;
    }
  }
}

__device__ __forceinline__ float red16(float v) { v += __shfl_xor(v, 1); v += __shfl_xor(v, 2); v += __shfl_xor(v, 4); v += __shfl_xor(v, 8); return v; }
__device__ void post_tile(const Params& P, int l, int rt, int ct, LAS char* lds) {
  const int tid_ = ltid(), lane = tid_ & 63, wid = tid_ >> 6;
  const bool latent = rt >= 32;
  half_t* P1 = (half_t*)(P.ws + WS_P1) + (size_t)tile_keyrow(rt) * P1W + ct * 256 + lane * 4;
  float* out = P.out;
  const float qs = 0.125f * LOG2E;
  f32x4 gvec = (f32x4){1.f, 1.f, 1.f, 1.f};
  if (ct == 0) gvec = *(const f32x4*)(P.in[I_QNORM] + l * 256 + lane * 4);
  else if (ct == 1) { if (lane < 32) gvec = *(const f32x4*)(P.in[I_KVNORM] + l * 128 + lane * 4); }
  else if (ct == 8 || ct == 9) gvec = *(const f32x4*)(P.in[I_GQN] + l * 64 + (lane & 15) * 4);
  else if (ct == 10) { if (lane < 32) gvec = *(const f32x4*)(P.in[I_GKN] + l * 64 + (lane & 15) * 4); }
  const bool rope64 = latent && ((ct >= 2 && ct <= 5) || ct == 8 || ct == 9 || (ct == 10 && lane < 32));
  const bool rope32 = latent && ct == 1 && lane >= 32 && lane < 40;
  const bool second = (ct == 1) ? (lane >= 36) : ((lane & 8) != 0);
  const int ridx = (ct == 1) ? ((lane & 3) * 4) : ((lane & 7) * 4);
  constexpr int RG = 8;
  const bool anyrope = latent && (ct <= 5 || ct >= 8) && ct <= 10 && ct != 0;
  const float* tbase = rope32 ? (const float*)(P.ws + WS_ROPE32) + ridx * 2 : (const float*)(P.ws + WS_ROPE64) + ridx * 2;
  const int tstride = rope32 ? 32 : 64;
  const int pos0 = latent ? ((rt - 32) & 7) * 256 + wid * 32 : 0;
  f32x4 csA[RG], csB[RG];
  if (anyrope && (rope64 || rope32)) {
#pragma unroll
    for (int q = 0; q < RG; ++q) { const float* tb = tbase + (size_t)(pos0 + q) * tstride; csA[q] = *(const f32x4*)tb; csB[q] = *(const f32x4*)(tb + 4); }
  }
  for (int r0 = 0; r0 < 32; r0 += RG) {
    f32x4 v[RG], cA[RG], cB[RG];
#pragma unroll
    for (int q = 0; q < RG; ++q) { v[q] = to_f32x4(*(LAS half4*)(lds + (wid * 32 + r0 + q) * TSTR + lane * 8)); cA[q] = csA[q]; cB[q] = csB[q]; }
    if (anyrope && (rope64 || rope32) && r0 + RG < 32) {
#pragma unroll
      for (int q = 0; q < RG; ++q) { const float* tb = tbase + (size_t)(pos0 + r0 + RG + q) * tstride; csA[q] = *(const f32x4*)tb; csB[q] = *(const f32x4*)(tb + 4); }
    }
    if (ct == 0 || ct == 1 || ct == 8 || ct == 9 || ct == 10) {
      float ss[RG];
#pragma unroll
      for (int q = 0; q < RG; ++q) { ss[q] = v[q][0] * v[q][0] + v[q][1] * v[q][1] + v[q][2] * v[q][2] + v[q][3] * v[q][3]; if (ct == 1 && lane >= 32) ss[q] = 0.f; }
      if (ct <= 1) {
#pragma unroll
        for (int o = 1; o < 64; o <<= 1)
#pragma unroll
          for (int q = 0; q < RG; ++q) ss[q] += __shfl_xor(ss[q], o);
      } else {
#pragma unroll
        for (int o = 1; o < 16; o <<= 1)
#pragma unroll
          for (int q = 0; q < RG; ++q) ss[q] += __shfl_xor(ss[q], o);
      }
      const float inv_n = (ct == 0) ? (1.0f / 256.0f) : (ct == 1) ? (1.0f / 128.0f) : (1.0f / 64.0f);
      const bool doit = (ct == 0) || (ct == 1 && lane < 32) || ct == 8 || ct == 9 || (ct == 10 && lane < 32);
      if (doit) {
#pragma unroll
        for (int q = 0; q < RG; ++q) { const float rs = rsqrtf(ss[q] * inv_n + EPS); v[q] = v[q] * rs * gvec; }
      }
    }
    if (anyrope) {
      f32x4 pv[RG];
#pragma unroll
      for (int q = 0; q < RG; ++q)
#pragma unroll
        for (int j = 0; j < 4; ++j) pv[q][j] = __shfl_xor(v[q][j], (ct == 1) ? 4 : 8);
      if (rope64 || rope32) {
#pragma unroll
        for (int q = 0; q < RG; ++q) {
          const float c[4] = {cA[q][0], cA[q][2], cB[q][0], cB[q][2]}, sn[4] = {cA[q][1], cA[q][3], cB[q][1], cB[q][3]};
#pragma unroll
          for (int j = 0; j < 4; ++j) v[q][j] = second ? (pv[q][j] * sn[j] + v[q][j] * c[j]) : (v[q][j] * c[j] - pv[q][j] * sn[j]);
        }
      }
    }
    if (ct == 2 || ct == 3 || ct == 8 || ct == 9) {
#pragma unroll
      for (int q = 0; q < RG; ++q) v[q] = v[q] * qs;
    }
#pragma unroll
    for (int q = 0; q < RG; ++q) {
      const int r = wid * 32 + r0 + q;
      *(half4*)(P1 + (size_t)r * P1W) = to_half4(v[q]);
      if (!latent) {
        const size_t sidx = ((size_t)rt * 2 + l) * 256 + r;
        if (ct == 1) { if (lane < 32) *(f32x4*)(out + O_CKV + sidx * 128 + lane * 4) = v[q]; else if (lane < 40) *(f32x4*)(out + O_KROPE + sidx * 32 + (lane - 32) * 4) = v[q]; }
        else if (ct == 4 || ct == 5) *(f32x4*)(out + O_DK + sidx * 512 + (ct - 4) * 256 + lane * 4) = v[q];
        else if (ct == 6 || ct == 7) *(f32x4*)(out + O_DV + sidx * 512 + (ct - 6) * 256 + lane * 4) = v[q];
        else if (ct == 10) { if (lane < 32) *(f32x4*)(out + O_GK + sidx * 128 + lane * 4) = v[q]; else *(f32x4*)(out + O_GV + sidx * 128 + (lane - 32) * 4) = v[q]; }
      }
    }
  }
}

__device__ void phase_gemm1(const Params& P, int l, LAS char* lds) {
  const half_t* H = (const half_t*)(P.ws + WS_H);
  const half_t* W = (const half_t*)(P.ws + WS_WIN) + (size_t)l * NW1 * WINP;
  half_t* SG = (half_t*)(P.ws + WS_SG);
  constexpr int NCT = 21, NU = 48 * NCT, NCACHE = 2 * PAST / 8;
  for (int uu = blockIdx.x; uu < NU + NCACHE; uu += gridDim.x) {
    if (uu >= NU) {
      const int tid_ = ltid(), lane = tid_ & 63, wid = tid_ >> 6;
      const int j = (uu - NU) * 8 + wid, b = j >> 9, s = j & 511;
      half_t* row = (half_t*)(P.ws + WS_P1) + (size_t)(8192 + b * LKEYS + s) * P1W;
      const size_t cb = ((size_t)b * 2 + l) * PAST + s;
      const float* ckv = P.in[I_CCKV] + cb * 128; const float* kro = P.in[I_CKROPE] + cb * 32;
      const float* dk = P.in[I_CDK] + cb * 512;   const float* dv = P.in[I_CDV] + cb * 512;
      const float* gk = P.in[I_CGK] + cb * 128;   const float* gv = P.in[I_CGV] + cb * 128;
      if (lane < 32) {
        *(half4*)(row + C_KVA + lane * 4) = to_half4(*(const f32x4*)(ckv + lane * 4));
        *(half4*)(row + C_GK + lane * 4) = to_half4(*(const f32x4*)(gk + lane * 4));
        *(half4*)(row + C_GV + lane * 4) = to_half4(*(const f32x4*)(gv + lane * 4));
        *(half4*)(row + C_KPE + lane * 4) = to_half4(lane < 8 ? *(const f32x4*)(kro + lane * 4) : (f32x4){0.f, 0.f, 0.f, 0.f});
      }
#pragma unroll
      for (int i = 0; i < 2; ++i) {
        *(half4*)(row + C_DK + (i * 64 + lane) * 4) = to_half4(*(const f32x4*)(dk + (i * 64 + lane) * 4));
        *(half4*)(row + C_DV + (i * 64 + lane) * 4) = to_half4(*(const f32x4*)(dv + (i * 64 + lane) * 4));
      }
      continue;
    }
    const int u = uu;
    const int ci = u / 48, rt = u % 48;
    const int ct = (ci < 16) ? ((ci & 1) ? 13 + (ci >> 1) : (ci >> 1)) : ci - 8;
    f32x4 acc[2][2][4][2]; zero_acc256(acc);
    gemm256_kloop(acc, H + (size_t)rt * 256 * HP, HP, W + (size_t)ct * 256 * WINP, WINP, 1024, lds);
    if (ct < 13) {
      stage_full256(acc, lds);
      __syncthreads();
      post_tile(P, l, rt, ct, lds);
      __syncthreads();
      continue;
    }
#pragma unroll
    for (int a = 0; a < 2; ++a)
#pragma unroll
      for (int b2 = 0; b2 < 2; ++b2)
#pragma unroll
        for (int m = 0; m < 4; ++m)
#pragma unroll
          for (int n = 0; n < 2; ++n)
#pragma unroll
            for (int j = 0; j < 4; ++j) acc[a][b2][m][n][j] = siluf_(acc[a][b2][m][n][j]);
    half_t* dst = SG + (size_t)rt * 256 * SGW + (ct - 13) * 256;
    stage_full256(acc, lds);
    drain_full256(lds, [&](int row, int c8, half8 v) { *(half8*)(dst + (size_t)row * SGW + c8) = v; });
  }
}

template <bool STATE_ONLY> __device__ void ssm_tile(const Params& P, int l, int rt, int oct, LAS char* lds);
__device__ void phase_gemm2(const Params& P, int l, LAS char* lds) {
  const half_t* P1 = (const half_t*)(P.ws + WS_P1);
  const half_t* WQ = (const half_t*)(P.ws + WS_WQB) + (size_t)l * 768 * WQBP;
  const half_t* WK = (const half_t*)(P.ws + WS_WKVB) + (size_t)l * 1024 * WKVBP;
  half_t* QA = (half_t*)(P.ws + WS_QA); half_t* KVA = (half_t*)(P.ws + WS_KVA);
  constexpr int NUS = 64, NUQ = 48 * 6, NUK = 52 * 8;
  const float qscale = 0.10206207261596575f * LOG2E;
  for (int uu = blockIdx.x; uu < NUS + NUQ + NUK; uu += gridDim.x) {
    if (uu < NUS) { ssm_tile<true>(P, l, 32 + (uu >> 2), uu & 3, lds); __syncthreads(); continue; }
    const int u = uu - NUS;
    f32x4 acc[4][4]; zero_acc(acc);
    if (u < NUQ) {
      const int ct = u / 48, rt = u % 48;
      gemm_kloop(acc, P1 + (size_t)tile_keyrow(rt) * P1W + C_QA, P1W, WQ + (size_t)ct * 128 * WQBP, WQBP, 256, lds);
      {
        EPI_COORDS
        const bool latent = rt >= 32;
#pragma unroll
        for (int m = 0; m < 4; ++m) {
          const int r = rt * 256 + wr * 64 + m * 16 + fr;
          const float* r32 = (const float*)(P.ws + WS_ROPE32) + (size_t)(latent ? ((r - NPT) & 2047) : 0) * 32;
#pragma unroll
          for (int np = 0; np < 2; ++np) {
            const int cb = ct * 128 + wc * 64 + np * 32;
            f32x4 v0 = acc[m][np * 2], v1 = acc[m][np * 2 + 1];
            if (latent && (cb % 96) == 64) {
#pragma unroll
              for (int j = 0; j < 4; ++j) { const int a = fq * 4 + j; const float c = r32[a * 2], s = r32[a * 2 + 1];
                const float x1 = v0[j], x2 = v1[j]; v0[j] = x1 * c - x2 * s; v1[j] = x1 * s + x2 * c; }
            }
            acc[m][np * 2] = v0 * qscale; acc[m][np * 2 + 1] = v1 * qscale;
          }
        }
      }
      stage_tile(acc, lds);
      half_t* dst = QA + (size_t)rt * 256 * QAP + ct * 128;
      drain_tile(lds, [&](int row, int c8, half8 v) { *(half8*)(dst + (size_t)row * QAP + c8) = v; });
    } else {
      const int v = u - NUQ, ct = v / 52, rt = v % 52;
      gemm_kloop(acc, P1 + (size_t)rt * 256 * P1W + C_KVA, P1W, WK + (size_t)ct * 128 * WKVBP, WKVBP, 128, lds);
      stage_tile(acc, lds);
      half_t* dst = KVA + (size_t)rt * 256 * KVP + ct * 128;
      drain_tile(lds, [&](int row, int c8, half8 vv) { *(half8*)(dst + (size_t)row * KVP + c8) = vv; });
    }
  }
}

__device__ __forceinline__ int crow(int r, int hi) { return (r & 3) + 8 * (r >> 2) + 4 * hi; }
constexpr int KSTR = 64 * 16 + 16;
constexpr int ATT_NST = 3;
template <int NCH1, int NCH2, int DV>
__device__ __forceinline__ void attn_pass(const half_t* __restrict__ Q, int ldq, const half_t* __restrict__ K1, int ldk1, const half_t* __restrict__ K2, int ldk2,
                                          const half_t* __restrict__ V, int ldv, int nkeys, LAS char* lds, f32x16 (&o)[DV / 32], float& linv, int pf = 0) {
  constexpr int NCH = NCH1 + NCH2, ND0 = NCH / 2, NDB = DV / 32;
  constexpr int KSL = ((NCH * KSTR + 255) / 256) * 256, VSL = NDB * 4096, VOFF0 = ATT_NST * KSL;
  constexpr int PKW = (NCH + 7) / 8, PVW = (NDB * 4) / 8;
  const int tid = ltid(), lane = tid & 63, wid = __builtin_amdgcn_readfirstlane(tid >> 6), r32 = lane & 31, hi = lane >> 5;
  half8 qf[ND0];
  {
    const half_t* qp = Q + (size_t)(wid * 32 + r32) * ldq + hi * 8;
#pragma unroll
    for (int d0 = 0; d0 < ND0; ++d0) qf[d0] = *(const half8*)(qp + d0 * 16);
  }
  const half_t* kbase[PKW]; int kld[PKW], kdst[PKW];
  const half_t* vbase[PVW]; int vdst[PVW], vlo[PVW];
#pragma unroll
  for (int i = 0; i < PKW; ++i) {
    int c = wid + 8 * i; if (c >= NCH) c = wid;
    kdst[i] = c * KSTR;
    if (c < NCH1) { kbase[i] = K1 + c * 8; kld[i] = ldk1; } else { kbase[i] = K2 + (c - NCH1) * 8; kld[i] = ldk2; }
  }
#pragma unroll
  for (int i = 0; i < PVW; ++i) {
    const int q = wid + 8 * i, dblk = q >> 2, rg = q & 3;
    vdst[i] = VOFF0 + dblk * 4096 + rg * 1024;
    vbase[i] = V + (size_t)(rg * 16) * ldv + dblk * 32;
    vlo[i] = (lane >> 2) * ldv + (lane & 3) * 8;
  }
  const int nt = nkeys >> 6;
  LAS char* ldl = lds + lane * 16;
#define AT_KDMA(t, sl) do { _Pragma("unroll") for (int i = 0; i < PKW; ++i) glds16(kbase[i] + (size_t)(((t) * 64 + lane) * kld[i]), ldl + (sl) * KSL + kdst[i]); } while (0)
#define AT_VDMA(t, sl) do { _Pragma("unroll") for (int i = 0; i < PVW; ++i) glds16(vbase[i] + (size_t)(t) * 64 * ldv + vlo[i], ldl + (sl) * VSL + vdst[i]); } while (0)
#define AT_VMWAIT(full) do { if (full) { if (PKW + PVW == 2) WAIT_V(2); else if (PKW + PVW == 3) WAIT_V(3); else WAIT_V(4); } else WAIT_V(0); } while (0)
#define AT_NEXT(x) (((x) == ATT_NST - 1) ? 0 : (x) + 1)
  const int la = wid >> 2;
  AT_KDMA(0, 0); AT_KDMA(1, 1); AT_VDMA(0, 0);
  if (la) { AT_KDMA(2, 2); AT_VDMA(1, 1); }
  WAIT_V(0);
  __syncthreads();
  float mrun = 0.f;
  f32x16 negm;
  float lrun = 0.f;
#pragma unroll
  for (int r = 0; r < 16; ++r) negm[r] = 0.f;
  half8 ones;
#pragma unroll
  for (int j = 0; j < 8; ++j) ones[j] = (half_t)1.0f;
#pragma unroll
  for (int d = 0; d < NDB; ++d)
#pragma unroll
    for (int r = 0; r < 16; ++r) o[d][r] = 0.f;
  const int koff = hi * KSTR + r32 * 16;
  const int voff = VOFF0 + (4 * hi + ((lane & 15) >> 2)) * 64 + ((lane >> 4) & 1) * 32 + (lane & 3) * 8;
  half8 pb[4];
  typedef short s16x8 __attribute__((ext_vector_type(8)));
  constexpr int NPV = (NDB / 2) * 4;
  v4i16_t vl_[NPV][2], vh_[NPV][2]; half8 kf_[ND0][2];
  f32x16 p0, p1;
  const unsigned ldsb = (unsigned)(size_t)lds;
  unsigned vfb = 0, kfb = 0;
  auto lds_wait4 = [&](auto nc, auto& A, auto& B, auto& C, auto& D) {
    constexpr int n = decltype(nc)::value;
    if constexpr (n == 0) asm volatile("s_waitcnt lgkmcnt(0)" : "+v"(A), "+v"(B), "+v"(C), "+v"(D));
    else if constexpr (n == 2) asm volatile("s_waitcnt lgkmcnt(2)" : "+v"(A), "+v"(B), "+v"(C), "+v"(D));
    else if constexpr (n == 4) asm volatile("s_waitcnt lgkmcnt(4)" : "+v"(A), "+v"(B), "+v"(C), "+v"(D));
    else if constexpr (n == 6) asm volatile("s_waitcnt lgkmcnt(6)" : "+v"(A), "+v"(B), "+v"(C), "+v"(D));
    else asm volatile("s_waitcnt lgkmcnt(8)" : "+v"(A), "+v"(B), "+v"(C), "+v"(D));
  };
  auto lds_wait2 = [&](auto nc, auto& A, auto& B) {
    constexpr int n = decltype(nc)::value;
    if constexpr (n == 0) asm volatile("s_waitcnt lgkmcnt(0)" : "+v"(A), "+v"(B));
    else if constexpr (n == 2) asm volatile("s_waitcnt lgkmcnt(2)" : "+v"(A), "+v"(B));
    else if constexpr (n == 4) asm volatile("s_waitcnt lgkmcnt(4)" : "+v"(A), "+v"(B));
    else if constexpr (n == 6) asm volatile("s_waitcnt lgkmcnt(6)" : "+v"(A), "+v"(B));
    else asm volatile("s_waitcnt lgkmcnt(8)" : "+v"(A), "+v"(B));
  };
  auto rop = [&vl_, &vh_, &kf_, &vfb, &kfb](auto uc, auto pc) {
    constexpr int u = decltype(uc)::value, PVN = decltype(pc)::value;
    if constexpr (u < PVN) {
      constexpr int dh_ = (u >> 2) * 2, s_ = u & 3;
      asm volatile("ds_read_b64_tr_b16 %0, %1 offset:%2" : "=v"(vl_[u % NPV][0]) : "v"(vfb), "i"(s_ * 1024 + dh_ * 4096));
      asm volatile("ds_read_b64_tr_b16 %0, %1 offset:%2" : "=v"(vh_[u % NPV][0]) : "v"(vfb), "i"(s_ * 1024 + dh_ * 4096 + 512));
      asm volatile("ds_read_b64_tr_b16 %0, %1 offset:%2" : "=v"(vl_[u % NPV][1]) : "v"(vfb), "i"(s_ * 1024 + (dh_ + 1) * 4096));
      asm volatile("ds_read_b64_tr_b16 %0, %1 offset:%2" : "=v"(vh_[u % NPV][1]) : "v"(vfb), "i"(s_ * 1024 + (dh_ + 1) * 4096 + 512));
    } else if constexpr (u < PVN + ND0) {
      constexpr int d0_ = u - PVN;
      asm volatile("ds_read_b128 %0, %1 offset:%2" : "=v"(kf_[d0_][0]) : "v"(kfb), "i"(d0_ * 2 * KSTR));
      asm volatile("ds_read_b128 %0, %1 offset:%2" : "=v"(kf_[d0_][1]) : "v"(kfb), "i"(d0_ * 2 * KSTR + 512));
    }
  };
  auto mop = [&](auto uc, auto pc, auto nopsc) {
    constexpr int u = decltype(uc)::value, PVN = decltype(pc)::value, NOPS = decltype(nopsc)::value;
    constexpr int n1 = (u + 1 >= NOPS) ? 0 : ((u + 1 < PVN) ? 4 : 2), n2 = (u + 2 >= NOPS) ? 0 : ((u + 2 < PVN) ? 4 : 2);
    if constexpr (u < PVN) {
      constexpr int dh_ = (u >> 2) * 2, s_ = u & 3;
      lds_wait4(std::integral_constant<int, n1 + n2>{}, vl_[u % NPV][0], vh_[u % NPV][0], vl_[u % NPV][1], vh_[u % NPV][1]);
#pragma unroll
      for (int dd = 0; dd < 2; ++dd) {
        const s16x8 vv = (s16x8){vl_[u % NPV][dd][0], vl_[u % NPV][dd][1], vl_[u % NPV][dd][2], vl_[u % NPV][dd][3], vh_[u % NPV][dd][0], vh_[u % NPV][dd][1], vh_[u % NPV][dd][2], vh_[u % NPV][dd][3]};
        o[dh_ + dd] = __builtin_amdgcn_mfma_f32_32x32x16_f16(__builtin_bit_cast(half8, vv), pb[s_], o[dh_ + dd], 0, 0, 0);
      }
    } else {
      constexpr int d0_ = u - PVN;
      lds_wait2(std::integral_constant<int, n1 + n2>{}, kf_[d0_][0], kf_[d0_][1]);
      if constexpr (d0_ == 0) { p0 = __builtin_amdgcn_mfma_f32_32x32x16_f16(kf_[0][0], qf[0], negm, 0, 0, 0); p1 = __builtin_amdgcn_mfma_f32_32x32x16_f16(kf_[0][1], qf[0], negm, 0, 0, 0); }
      else { p0 = __builtin_amdgcn_mfma_f32_32x32x16_f16(kf_[d0_][0], qf[d0_], p0, 0, 0, 0); p1 = __builtin_amdgcn_mfma_f32_32x32x16_f16(kf_[d0_][1], qf[d0_], p1, 0, 0, 0); }
    }
  };
  auto mhalf = [&](auto pc, auto nopsc, int vsl, int ksl) {
    constexpr int NOPS = decltype(nopsc)::value;
    vfb = ldsb + vsl * VSL + voff; kfb = ldsb + ksl * KSL + koff;
    rop(std::integral_constant<int, 0>{}, pc); rop(std::integral_constant<int, 1>{}, pc);
    __builtin_amdgcn_sched_barrier(0);
    static_for<NOPS>([&](auto uc) {
      constexpr int u = decltype(uc)::value;
      rop(std::integral_constant<int, u + 2>{}, pc);
      mop(uc, pc, nopsc);
      __builtin_amdgcn_sched_barrier(0);
    });
  };
  int s0 = 0, s1 = 1, s2 = 2;
  bool fullB = true;
  if (la) BAR();
  for (int t = 0; t < nt; ++t) {
    const bool fullA = (t + 2 < nt);
    if (!la) { if (t + 2 < nt) AT_KDMA(t + 2, s2); if (t + 1 < nt) AT_VDMA(t + 1, s1); }
    __builtin_amdgcn_s_setprio(1);
    if (t > 0) mhalf(std::integral_constant<int, NPV>{}, std::integral_constant<int, NPV + ND0>{}, s2, s0);
    else mhalf(std::integral_constant<int, 0>{}, std::integral_constant<int, ND0>{}, s2, s0);
    __builtin_amdgcn_s_setprio(0);
    if (la) AT_VMWAIT(fullB);
    BAR();
    if (la) { if (t + 3 < nt) AT_KDMA(t + 3, s0); if (t + 2 < nt) AT_VDMA(t + 2, s2); fullB = (t + 3 < nt); }
    int mb = max(__float_as_int(p0[0]), __float_as_int(p1[0]));
#pragma unroll
    for (int r = 1; r < 16; ++r) mb = max(mb, max(__float_as_int(p0[r]), __float_as_int(p1[r])));
    if (t == 0 || __any(mb > 0x41000000)) {
      float mx = fmaxf(p0[0], p1[0]);
#pragma unroll
      for (int r = 1; r < 16; ++r) mx = fmaxf(mx, fmaxf(p0[r], p1[r]));
      mx = swap_max(mx);
      const float dl = (t == 0) ? mx : fmaxf(mx, 0.f);
      const float alpha = __builtin_amdgcn_exp2f(-dl);
      mrun += dl;
#pragma unroll
      for (int r = 0; r < 16; ++r) { p0[r] -= dl; p1[r] -= dl; negm[r] = -mrun; }
      lrun *= alpha;
#pragma unroll
      for (int d = 0; d < NDB; ++d)
#pragma unroll
        for (int r = 0; r < 16; ++r) o[d][r] *= alpha;
    }
    float ps0 = 0.f, ps1 = 0.f;
#pragma unroll
    for (int r = 0; r < 16; ++r) { p0[r] = __builtin_amdgcn_exp2f(p0[r]); p1[r] = __builtin_amdgcn_exp2f(p1[r]); ps0 += p0[r]; ps1 += p1[r]; }
    lrun += ps0 + ps1;
#pragma unroll
    for (int j = 0; j < 8; ++j) { pb[0][j] = (half_t)p0[j]; pb[1][j] = (half_t)p0[8 + j]; pb[2][j] = (half_t)p1[j]; pb[3][j] = (half_t)p1[8 + j]; }
    if (!la) AT_VMWAIT(fullA);
    BAR();
    { const int tmp = s0; s0 = s1; s1 = s2; s2 = tmp; }
  }
  mhalf(std::integral_constant<int, NPV>{}, std::integral_constant<int, NPV>{}, s2, s0);
  if (!la) BAR();
#undef AT_NEXT
#undef AT_KDMA
#undef AT_VDMA
#undef AT_VMWAIT
  linv = 1.0f / swap_add(lrun);
  __syncthreads();
}

struct AttnGeom { int tok0, key0, nkeys, mrow; };
__device__ __forceinline__ AttnGeom attn_geom(bool latent, int b, int qb) {
  AttnGeom g;
  if (latent) { g.tok0 = NPT + b * LSEQ + qb * 256; g.key0 = 8192 + b * LKEYS; g.nkeys = LKEYS; }
  else { g.tok0 = b * 256; g.key0 = b * 256; g.nkeys = 256; }
  g.mrow = 0; return g;
}

template <int DV>
__device__ __forceinline__ void attn_prefetch_g(half8 (&gp)[DV / 16], const half_t* sg0) {
  constexpr int CH = DV / 8;
  const int lane = ltid() & 63;
#pragma unroll
  for (int i = 0; i < 32 * CH / 64; ++i) { const int idx = i * 64 + lane, row = idx / CH, ch = idx % CH; gp[i] = *(const half8*)(sg0 + (size_t)row * SGW + ch * 8); }
}
template <int DV>
__device__ __forceinline__ void attn_epilogue(const f32x16 (&o)[DV / 32], float scale, const float* sub, LAS char* st, half_t* sg0, int dry, const half8 (&gp)[DV / 16]) {
  constexpr int ROWB = DV * 2 + 16, CH = DV / 8;
  const int tid_ = ltid(), lane = tid_ & 63, r32 = lane & 31, hi = lane >> 5;
#pragma unroll
  for (int d = 0; d < DV / 32; ++d)
#pragma unroll
    for (int q = 0; q < 4; ++q) {
      const int dv = d * 32 + q * 8 + hi * 4;
      f32x4 v; v[0] = o[d][q * 4] * scale; v[1] = o[d][q * 4 + 1] * scale; v[2] = o[d][q * 4 + 2] * scale; v[3] = o[d][q * 4 + 3] * scale;
      if (sub) { const f32x4 sb = *(const f32x4*)(sub + dv); v = v * sb; }
      *(LAS half4*)(st + r32 * ROWB + dv * 2) = to_half4(v);
    }
#pragma unroll
  for (int i = 0; i < 32 * CH / 64; ++i) {
    const int idx = i * 64 + lane, row = idx / CH, ch = idx % CH;
    const half8 v = *(LAS half8*)(st + row * ROWB + ch * 16);
    half_t* p = sg0 + (size_t)row * SGW + ch * 8;
    const half8 g = gp[i];
    half8 r = v * g;
    if (dry == 2) { const bool odd = ((float)r[0] == 12345.678f); r = odd ? r : g; }
    if (dry != 1) *(half8*)p = r;
  }
}

__device__ void mla_unit(const Params& P, bool latent, int b, int qb, int h, LAS char* lds, int dry) {
  const AttnGeom g = attn_geom(latent, b, qb);
  const half_t* QA = (const half_t*)(P.ws + WS_QA) + (size_t)g.tok0 * QAP + h * 96;
  const half_t* KVA = (const half_t*)(P.ws + WS_KVA) + (size_t)g.key0 * KVP + h * 128;
  const half_t* P1 = (const half_t*)(P.ws + WS_P1) + (size_t)g.key0 * P1W;
  f32x16 o[2]; float linv;
  const int wid = ltid() >> 6;
  half_t* sg0 = (half_t*)(P.ws + WS_SG) + (size_t)(g.tok0 + wid * 32) * SGW + 0 * 512 + h * 64;
  half8 gp[4]; attn_prefetch_g<64>(gp, sg0);
  attn_pass<8, 4, 64>(QA, QAP, KVA, KVP, P1 + C_KPE, P1W, KVA + 64, KVP, g.nkeys, lds, o, linv);
  attn_epilogue<64>(o, linv, nullptr, lds + wid * 4608, sg0, dry, gp);
}
__device__ void gqa_unit(const Params& P, bool latent, int b, int qb, int h, LAS char* lds, int dry) {
  const AttnGeom g = attn_geom(latent, b, qb);
  const half_t* P1 = (const half_t*)(P.ws + WS_P1);
  const half_t* Q = P1 + (size_t)tok_keyrow(g.tok0) * P1W + C_GQ + h * 64;
  const half_t* Kp = P1 + (size_t)g.key0 * P1W + C_GK + (h >> 2) * 64;
  const half_t* Vp = P1 + (size_t)g.key0 * P1W + C_GV + (h >> 2) * 64;
  f32x16 o[2]; float linv;
  const int wid = ltid() >> 6;
  half_t* sg0 = (half_t*)(P.ws + WS_SG) + (size_t)(g.tok0 + wid * 32) * SGW + 2 * 512 + h * 64;
  half8 gp[4]; attn_prefetch_g<64>(gp, sg0);
  attn_pass<8, 0, 64>(Q, P1W, Kp, P1W, Kp, P1W, Vp, P1W, g.nkeys, lds, o, linv);
  attn_epilogue<64>(o, linv, nullptr, lds + wid * 4608, sg0, dry, gp);
}
constexpr int O1S_BASE = 3 * (8448 + 16384), O1S_STRIDE = 8704;
__device__ void diff_unit(const Params& P, int l, bool latent, int b, int qb, int h, LAS char* lds, int dry, int pf) {
  const AttnGeom g = attn_geom(latent, b, qb);
  const half_t* P1 = (const half_t*)(P.ws + WS_P1);
  const half_t* Qb = P1 + (size_t)tok_keyrow(g.tok0) * P1W + C_DQ + h * 128;
  const half_t* Kb = P1 + (size_t)g.key0 * P1W + C_DK + h * 128;
  const half_t* Vp = P1 + (size_t)g.key0 * P1W + C_DV + h * 128;
  f32x16 o2[4]; float l2;
  const int tid0 = ltid(), wid = tid0 >> 6;
  LAS char* o1w = lds + O1S_BASE + wid * O1S_STRIDE;
  LAS char* o1s = o1w + (tid0 & 63) * 16;
  {
    f32x16 o1[4]; float l1;
    attn_pass<8, 0, 128>(Qb, P1W, Kb, P1W, Kb, P1W, Vp, P1W, g.nkeys, lds, o1, l1, pf);
#pragma unroll
    for (int d = 0; d < 4; ++d)
#pragma unroll
      for (int q = 0; q < 2; ++q) {
        half8 hv;
#pragma unroll
        for (int j = 0; j < 8; ++j) hv[j] = (half_t)(o1[d][q * 8 + j] * l1);
        *(LAS half8*)(o1s + (d * 2 + q) * 1024) = hv;
      }
  }
  half_t* sg0 = (half_t*)(P.ws + WS_SG) + (size_t)(g.tok0 + wid * 32) * SGW + 1 * 512 + h * 128;
  half8 gp[8]; attn_prefetch_g<128>(gp, sg0);
  attn_pass<8, 0, 128>(Qb + 64, P1W, Kb + 64, P1W, Kb + 64, P1W, Vp, P1W, g.nkeys, lds, o2, l2, pf);
  const float lam = ((const float*)(P.ws + WS_LAM))[l];
  const float lam_init = 0.8f - 0.6f * expf(-0.3f * (float)l);
  const float l2l = l2 * lam;
  float ss = 0.f;
#pragma unroll
  for (int d = 0; d < 4; ++d)
#pragma unroll
    for (int q = 0; q < 2; ++q) {
      const half8 hv = *(LAS half8*)(o1s + (d * 2 + q) * 1024);
#pragma unroll
      for (int j = 0; j < 8; ++j) { const float v = (float)hv[j] - l2l * o2[d][q * 8 + j]; o2[d][q * 8 + j] = v; ss += v * v; }
    }
  ss = swap_add(ss);
  const float rstd = rsqrtf(ss * (1.0f / 128.0f) + EPS) * (1.0f - lam_init);
  attn_epilogue<128>(o2, rstd, P.in[I_SUBLN] + l * 128, o1w, sg0, dry, gp);
}

constexpr int SSM_BU = 16 * 272, SSM_HS = 16 * 272, SSM_D = SSM_BU + SSM_HS, SSM_W = 2 * SSM_D;
template <bool STATE_ONLY>
__device__ void ssm_tile(const Params& P, int l, int rt, int oct, LAS char* lds) {
  const int tid_ = ltid(), lane = tid_ & 63, wid = tid_ >> 6, fr = lane & 15, fq = lane >> 4;
  const int g = oct * 8 + wid;
  const bool latent = rt >= 32;
  const int tok0 = rt * 256, krow0 = tile_keyrow(rt);
  const int lb = (rt - 32) >> 3, lq = (rt - 32) & 7;
  LAS char* my = lds + wid * SSM_W;
  const half_t* P1 = (const half_t*)(P.ws + WS_P1);
  half_t* Y = (half_t*)(P.ws + WS_Y);
  float* HEND = (float*)(P.ws + WS_HEND);
  const f32x4 dco = *(const f32x4*)(P.in[I_SSMD] + l * 512 + g * 16 + fq * 4);
  half4 bmf[2][8]; half8 cmf[2][4]; float bsc[2], ar[2], ai[2], hr[2], hi_[2];
#pragma unroll
  for (int d = 0; d < 2; ++d) {
    const int idx = (l * 2 + d) * 32 + g;
    const half_t* bm = (const half_t*)(P.ws + WS_BM) + (size_t)idx * 2048;
    const half_t* cm = (const half_t*)(P.ws + WS_CM) + (size_t)idx * 2048;
#pragma unroll
    for (int tl = 0; tl < 8; ++tl) bmf[d][tl] = *(const half4*)(bm + (tl * 16 + fr) * 16 + fq * 4);
    if (!STATE_ONLY) {
#pragma unroll
      for (int ks = 0; ks < 4; ++ks) cmf[d][ks] = *(const half8*)(cm + fr * 128 + ks * 32 + fq * 8);
    }
    bsc[d] = ((const float*)(P.ws + WS_BSC))[idx];
    ar[d] = ((const float*)(P.ws + WS_ABAR))[((size_t)idx * 64 + lane) * 2]; ai[d] = ((const float*)(P.ws + WS_ABAR))[((size_t)idx * 64 + lane) * 2 + 1];
    hr[d] = 0.f; hi_[d] = 0.f;
    if (!STATE_ONLY && latent) {
      const float* st = P.in[I_STATE] + ((((size_t)lb * 2 + l) * 2 + d) * 32 + g) * 128 + lane * 2; hr[d] = st[0]; hi_[d] = st[1];
      const float a2r = ((const float*)(P.ws + WS_A256))[((size_t)idx * 64 + lane) * 2], a2i = ((const float*)(P.ws + WS_A256))[((size_t)idx * 64 + lane) * 2 + 1];
      const int nprev = d ? 7 - lq : lq;
      for (int i = 0; i < nprev; ++i) {
        const int jt = lb * 8 + (d ? 7 - i : i);
        const float* he = HEND + (((size_t)jt * 64 + d * 32 + g) * 64 + lane) * 2;
        const float er = __hip_atomic_load(he, __ATOMIC_RELAXED, __HIP_MEMORY_SCOPE_AGENT), ei = __hip_atomic_load(he + 1, __ATOMIC_RELAXED, __HIP_MEMORY_SCOPE_AGENT);
        const float nr = a2r * hr[d] - a2i * hi_[d] + er, ni = a2r * hi_[d] + a2i * hr[d] + ei; hr[d] = nr; hi_[d] = ni;
      }
    }
  }
  const half_t* up = P1 + (size_t)(krow0 + fr) * P1W + C_U + g * 16 + fq * 4;
  half_t* ybase = Y + (size_t)(tok0 + fr) * YP + g * 16 + fq * 4;
#define SSM_CH(d, ci) ((d) ? 15 - (ci) : (ci))
#define SSM_LOADU(c) (*(const half4*)(up + (size_t)((c) * 16) * P1W))
#define SSM_BU_MFMA(d, u_, d_) do { _Pragma("unroll") for (int tl = 0; tl < 8; ++tl) { d_[tl] = (f32x4){0.f, 0.f, 0.f, 0.f}; d_[tl] = __builtin_amdgcn_mfma_f32_16x16x16f16(bmf[d][tl], u_, d_[tl], 0, 0, 0); } } while (0)
#define SSM_BU_STORE(d, d_) do { _Pragma("unroll") for (int tl = 0; tl < 8; ++tl) *(LAS half4*)(my + (d) * SSM_D + fr * 272 + (tl * 16 + fq * 4) * 2) = to_half4(d_[tl]); } while (0)
  half4 uf[2], ufn[2];
#pragma unroll
  for (int d = 0; d < 2; ++d) { uf[d] = SSM_LOADU(SSM_CH(d, 0)); f32x4 d0[8]; SSM_BU_MFMA(d, uf[d], d0); SSM_BU_STORE(d, d0); ufn[d] = SSM_LOADU(SSM_CH(d, 1)); }
  unsigned long long pvn[2] = {0ull, 0ull};
#define SSM_LOADY(d, ci) __hip_atomic_load((const unsigned long long*)(ybase + (size_t)(SSM_CH(d, ci) * 16) * YP), __ATOMIC_RELAXED, __HIP_MEMORY_SCOPE_AGENT)
  for (int ci = 0; ci < 16; ++ci) {
    half2v bb[2][16]; half4 ufnn[2]; unsigned long long pv[2];
    if (!STATE_ONLY && ci == 8) { WAIT_V(0); pvn[0] = SSM_LOADY(0, 8); pvn[1] = SSM_LOADY(1, 8); }
    pv[0] = pvn[0]; pv[1] = pvn[1];
    if (!STATE_ONLY && ci >= 8 && ci + 1 < 16) { pvn[0] = SSM_LOADY(0, ci + 1); pvn[1] = SSM_LOADY(1, ci + 1); }
#pragma unroll
    for (int d = 0; d < 2; ++d) {
#pragma unroll
      for (int tt = 0; tt < 16; ++tt) bb[d][tt] = *(LAS half2v*)(my + d * SSM_D + tt * 272 + lane * 4);
      ufnn[d] = (ci + 2 < 16) ? SSM_LOADU(SSM_CH(d, ci + 2)) : ufn[d];
    }
#pragma unroll
    for (int tt = 0; tt < 16; ++tt) {
#pragma unroll
      for (int d = 0; d < 2; ++d) {
        const int t = d ? 15 - tt : tt;
        const float br = (float)bb[d][t][0] * bsc[d], bi = (float)bb[d][t][1] * bsc[d];
        const float nhr = ar[d] * hr[d] - ai[d] * hi_[d] + br, nhi = ar[d] * hi_[d] + ai[d] * hr[d] + bi;
        hr[d] = nhr; hi_[d] = nhi;
        if (!STATE_ONLY) *(LAS half2v*)(my + d * SSM_D + SSM_BU + t * 272 + lane * 4) = (half2v){(half_t)nhr, (half_t)nhi};
      }
    }
#pragma unroll
    for (int d = 0; d < 2; ++d) {
      if (ci + 1 < 16) { f32x4 dn[8]; SSM_BU_MFMA(d, ufn[d], dn); SSM_BU_STORE(d, dn); }
      if (!STATE_ONLY) {
        f32x4 yv = (f32x4){0.f, 0.f, 0.f, 0.f};
#pragma unroll
        for (int ks = 0; ks < 4; ++ks) {
          const half8 hs = *(LAS half8*)(my + d * SSM_D + SSM_BU + fr * 272 + (ks * 32 + fq * 8) * 2);
          yv = __builtin_amdgcn_mfma_f32_16x16x32_f16(cmf[d][ks], hs, yv, 0, 0, 0);
        }
        half_t* yp = ybase + (size_t)(SSM_CH(d, ci) * 16) * YP;
        if (ci < 8) { *(half4*)yp = to_half4(yv); }
        else {
          const f32x4 prev = to_f32x4(__builtin_bit_cast(half4, pv[d]));
          const f32x4 uu = to_f32x4(uf[d]);
          f32x4 o;
#pragma unroll
          for (int j = 0; j < 4; ++j) o[j] = gelu_tanh(yv[j] + prev[j] + dco[j] * uu[j]);
          *(half4*)yp = to_half4(o);
        }
      }
      uf[d] = ufn[d]; ufn[d] = ufnn[d];
    }
  }
#undef SSM_LOADY
#undef SSM_CH
#undef SSM_LOADU
#undef SSM_BU_MFMA
#undef SSM_BU_STORE
#pragma unroll
  for (int d = 0; d < 2; ++d) {
    if (STATE_ONLY) { float* he = HEND + (((size_t)(rt - 32) * 64 + d * 32 + g) * 64 + lane) * 2; he[0] = hr[d]; he[1] = hi_[d]; }
    else if (!latent) { float* so = P.out + O_ST + ((((size_t)(rt) * 2 + l) * 2 + d) * 32 + g) * 128 + lane * 2; so[0] = hr[d]; so[1] = hi_[d]; }
  }
}

__device__ void glu_unit(const Params& P, int l, int rt, int ct, LAS char* lds) {
  const half_t* Y = (const half_t*)(P.ws + WS_Y);
  const half_t* W = (const half_t*)(P.ws + WS_WGLU) + (size_t)l * 512 * WGLUP;
  half_t* SG = (half_t*)(P.ws + WS_SG);
  const float* gb = P.in[I_GLUB] + l * 512;
  {
    f32x4 acc[4][4]; zero_acc(acc);
    gemm_kloop(acc, Y + (size_t)rt * 256 * YP, YP, W + (size_t)ct * 128 * WGLUP, WGLUP, 512, lds);
    {
      EPI_COORDS
#pragma unroll
      for (int n = 0; n < 4; ++n) {
        const f32x4 bb = *(const f32x4*)(gb + ct * 128 + wc * 64 + n * 16 + fq * 4);
#pragma unroll
        for (int m = 0; m < 4; ++m)
#pragma unroll
          for (int j = 0; j < 4; ++j) acc[m][n][j] = sigmoidf_(acc[m][n][j] + bb[j]);
      }
    }
    const half_t* ysrc = Y + (size_t)rt * 256 * YP + ct * 128;
    half_t* sp = SG + (size_t)rt * 256 * SGW + 1536 + ct * 128;
    half8 yg[8];
    {
      const int tid = ltid();
#pragma unroll
      for (int i = 0; i < 8; ++i) {
        const int idx = i * 512 + tid, row = idx >> 4, c8 = (idx & 15) * 8;
        yg[i] = *(const half8*)(ysrc + (size_t)row * YP + c8) * *(const half8*)(sp + (size_t)row * SGW + c8);
      }
    }
    stage_tile(acc, lds);
    {
      const int tid = ltid();
      __syncthreads();
#pragma unroll
      for (int i = 0; i < 8; ++i) {
        const int idx = i * 512 + tid, row = idx >> 4, ch = idx & 15;
        const half8 v = *(LAS half8*)(lds + row * STG_ROWB + ch * 16);
        *(half8*)(sp + (size_t)row * SGW + ch * 8) = v * yg[i];
      }
      __syncthreads();
    }
  }
}

__device__ void phase_mix(const Params& P, int l, int inv, int modef, LAS char* lds) {
  const int mode = modef & 15;
  constexpr int U1 = 64, U2 = U1 + 128, U3 = U2 + 128, U4 = U3 + 192, U5 = U4 + 128, U6 = U5 + 256, U7 = U6 + 256, U8 = U7 + 192;
  unsigned* cntY = (unsigned*)(P.ws + WS_CTRL) + 10240 + (inv * 2 + l) * 64;
  unsigned* ctr = (unsigned*)(P.ws + WS_CTRL) + 8192 + (inv * 2 + l) * 64;
  LAS int* slot = (LAS int*)(lds + LDS_BYTES - 16);
  for (;;) {
    __syncthreads();
    if (threadIdx.x == 0) *slot = (int)atomicAdd(ctr, 1u);
    __syncthreads();
    const int u = *slot;
    if (u >= U8) break;
    int type, latent = 0, b = 0, qb = 0, h;
    if (u < U1) { const int v = u; type = 1; latent = 1; b = v >> 5; qb = (v >> 2) & 7; h = v & 3; }
    else if (u < U2) { const int v = u - U1; type = 0; latent = 1; b = v >> 6; qb = (v >> 3) & 7; h = v & 7; }
    else if (u < U3) { const int v = u - U2; type = 2; latent = 1; b = v >> 6; qb = (v >> 3) & 7; h = v & 7; }
    else if (u < U4) { const int v = u - U3; type = 3; b = 47 - (v >> 2); h = v & 3; }
    else if (u < U5) { const int v = u - U4; type = 1; b = v >> 2; h = v & 3; }
    else if (u < U6) { const int v = u - U5; type = 0; b = v >> 3; h = v & 7; }
    else if (u < U7) { const int v = u - U6; type = 2; b = v >> 3; h = v & 7; }
    else { const int v = u - U7; type = 4; b = 47 - (v >> 2); h = v & 3; }
    bool skip = false;
    if (mode != 0 && type == 4) skip = true;
    if (mode == 1 && type != 3) skip = true;
    if (mode == 2 && (type == 3 || !latent)) skip = true;
    if (mode == 3 && type == 3) skip = true;
    if (mode == 6 && type == 3) skip = true;
    if (mode == 7 && !(type == 1 && latent)) skip = true;
    if (mode == 8 && !(type == 0 && latent)) skip = true;
    if (mode == 9 && !(type == 2 && latent)) skip = true;
    if (mode == 10 && (type == 3 || latent)) skip = true;
    const int dry = (mode == 0) ? 0 : ((mode >= 5) ? 2 : 1);
    if (!skip) {
      if (type == 0) mla_unit(P, latent != 0, b, qb, h, lds, dry);
      else if (type == 1) diff_unit(P, l, latent != 0, b, qb, h, lds, dry, modef >> 4);
      else if (type == 2) gqa_unit(P, latent != 0, b, qb, h, lds, dry);
      else if (type == 3) {
        ssm_tile<false>(P, l, b, h, lds);
        asm volatile("s_waitcnt vmcnt(0)" ::: "memory");
        __syncthreads();
        if (threadIdx.x == 0) {
          __builtin_amdgcn_fence(__ATOMIC_RELEASE, "agent");
          asm volatile("s_waitcnt vmcnt(0)" ::: "memory");
          if (mode == 0) __hip_atomic_fetch_add(&cntY[b], 1u, __ATOMIC_RELAXED, __HIP_MEMORY_SCOPE_AGENT);
        }
      } else {
        if (threadIdx.x == 0) {
          unsigned sp = 0;
          while (__hip_atomic_load(&cntY[b], __ATOMIC_RELAXED, __HIP_MEMORY_SCOPE_AGENT) < 4u) { __builtin_amdgcn_s_sleep(2); if (++sp > (1u << 24)) break; }
          __builtin_amdgcn_fence(__ATOMIC_ACQUIRE, "agent");
          asm volatile("s_waitcnt vmcnt(0)" ::: "memory");
        }
        __syncthreads();
        glu_unit(P, l, b, h, lds);
      }
    }
  }
}

__device__ void phase_branch(const Params& P, int l, LAS char* lds, int kk = 512, int abl = 0) {
  const half_t* WBR = (const half_t*)(P.ws + WS_WBR) + (size_t)l * 4 * 1024 * WBRP;
  const half_t* ABR = (const half_t*)(P.ws + WS_SG);
  half_t* BRO = (half_t*)(P.ws + WS_BRO);
  for (int u = blockIdx.x; u < 48 * 16; u += gridDim.x) {
    const int ct = u / 48, rt = u % 48, nb = ct >> 2;
    f32x4 acc[2][2][4][2]; zero_acc256(acc);
    gemm256_kloop(acc, ABR + (size_t)rt * 256 * SGW + nb * 512, SGW, WBR + (size_t)ct * 256 * WBRP, WBRP, kk, lds, 0, 128, abl);
    half_t* dst = BRO + (size_t)rt * 256 * BROP + ct * 256;
    if (abl & 8) continue;
    stage_full256(acc, lds);
    drain_full256(lds, [&](int row, int c8, half8 v) { *(half8*)(dst + (size_t)row * BROP + c8) = v; });
  }
}

__device__ void phase_merge(const Params& P, int l, LAS char* lds) {
  const half_t* H = (const half_t*)(P.ws + WS_H);
  const half_t* WM = (const half_t*)(P.ws + WS_WIN) + (size_t)l * NW1 * WINP + (size_t)5376 * WINP;
  const half_t* BRO = (const half_t*)(P.ws + WS_BRO);
  half_t* MG = (half_t*)(P.ws + WS_MG);
  for (int u = blockIdx.x; u < 48 * 16; u += gridDim.x) {
    const int dt = u / 48, rt = u % 48;
    f32x4 acc[2][2][4][2]; zero_acc256(acc);
    gemm256_kloop(acc, H + (size_t)rt * 256 * HP, HP, WM + (size_t)dt * 64 * WINP, WINP, 1024, lds, 960, 2048);
    const int tid = ltid();
    f32x4 sum[4][2];
    half8 bro[2][4][2];
#define M2_LOAD(bj) do { _Pragma("unroll") for (int i = 0; i < 4; ++i) { const int idx = i * 512 + tid, row = idx >> 3, c8 = (idx & 7) * 8; \
      const half_t* bp = BRO + (size_t)(rt * 256 + row) * BROP + (2 * (bj)) * 1024 + dt * 64 + c8; bro[bj][i][0] = *(const half8*)bp; bro[bj][i][1] = *(const half8*)(bp + 1024); } } while (0)
    M2_LOAD(0);
#pragma unroll
    for (int a = 0; a < 2; ++a)
#pragma unroll
      for (int b2 = 0; b2 < 2; ++b2)
#pragma unroll
        for (int m = 0; m < 4; ++m)
#pragma unroll
          for (int n = 0; n < 2; ++n)
#pragma unroll
            for (int j = 0; j < 4; ++j) acc[a][b2][m][n][j] = sigmoidf_(acc[a][b2][m][n][j]);
#pragma unroll
    for (int bj = 0; bj < 2; ++bj) {
      stage_half256(acc, bj, lds);
      if (bj == 0) M2_LOAD(1);
      __syncthreads();
#pragma unroll
      for (int i = 0; i < 4; ++i) {
        const int idx = i * 512 + tid, row = idx >> 3, c8 = (idx & 7) * 8;
        const half8 g0 = *(LAS half8*)(lds + row * STG_ROWB + c8 * 2), g1 = *(LAS half8*)(lds + row * STG_ROWB + (64 + c8) * 2);
#pragma unroll
        for (int j = 0; j < 8; ++j) {
          const float t = (float)g0[j] * (float)bro[bj][i][0][j] + (float)g1[j] * (float)bro[bj][i][1][j];
          if (bj == 0) sum[i][j >> 2][j & 3] = t; else sum[i][j >> 2][j & 3] += t;
        }
      }
      __syncthreads();
    }
#undef M2_LOAD
#pragma unroll
    for (int i = 0; i < 4; ++i) {
      const int idx = i * 512 + tid, row = idx >> 3, c8 = (idx & 7) * 8;
      half8 o;
#pragma unroll
      for (int j = 0; j < 8; ++j) o[j] = (half_t)sum[i][j >> 2][j & 3];
      *(half8*)(MG + (size_t)(rt * 256 + row) * MGP + dt * 64 + c8) = o;
    }
  }
}

__device__ void phase_out(const Params& P, int l, LAS char* lds) {
  const half_t* MG = (const half_t*)(P.ws + WS_MG);
  const half_t* W = (const half_t*)(P.ws + WS_WOUT) + (size_t)l * 1024 * WOUTP;
  for (int u = blockIdx.x; u < 48 * 4; u += gridDim.x) {
    const int ct = u / 48, rt = u % 48;
    f32x4 acc[2][2][4][2]; zero_acc256(acc);
    gemm256_kloop(acc, MG + (size_t)rt * 256 * MGP, MGP, W + (size_t)ct * 256 * WOUTP, WOUTP, 1024, lds);
    const int tid = ltid(), lane = tid & 63, wid = tid >> 6, wr = wid >> 2, wc = wid & 3, fr = lane & 15, fq = lane >> 4;
#pragma unroll
    for (int ai = 0; ai < 2; ++ai)
#pragma unroll
      for (int m = 0; m < 4; ++m) {
        const int r = rt * 256 + ai * 128 + wr * 64 + m * 16 + fr;
        const float* xr = xin_row(P, l, r);
        const float* ga = (const float*)(P.ws + WS_MOD) + ((size_t)l * 3 + tok_modrow(r)) * 3072 + 2048;
#pragma unroll
        for (int bj = 0; bj < 2; ++bj)
#pragma unroll
          for (int n = 0; n < 2; ++n) {
            const int c = ct * 256 + bj * 128 + wc * 32 + n * 16 + fq * 4;
            const f32x4 xv = *(const f32x4*)(xr + c), gv = *(const f32x4*)(ga + c);
            *(f32x4*)(P.out + (size_t)r * DM + c) = xv + gv * acc[ai][bj][m][n];
          }
      }
  }
}

#define XB_TMO      128
#define XB_XCNT(j)  (256  + 64 * (j))
#define XB_XSUB(j)  (1280 + 64 * (j))
#define XB_XGEN(j)  (2304 + 64 * (j))
#define XB_TOP      3328
#define XB_TOPGEN   3392
#define XB_SPIN_CAP (1u << 22)
__device__ __forceinline__ unsigned xb_ld(unsigned* p)              { return __hip_atomic_load(p, __ATOMIC_RELAXED, __HIP_MEMORY_SCOPE_AGENT); }
__device__ __forceinline__ unsigned xb_add(unsigned* p, unsigned v) { return __hip_atomic_fetch_add(p, v, __ATOMIC_RELAXED, __HIP_MEMORY_SCOPE_AGENT); }
__device__ __forceinline__ unsigned xb_xcc_id() { return (unsigned)__builtin_amdgcn_s_getreg((3 << 11) | 20) & 0xFu; }
#define XB_SPIN(cond, bar) do { unsigned _sp = 0; while (cond) { __builtin_amdgcn_s_sleep(1); \
    if ((++_sp & 255u) == 0u) { if (xb_ld(&(bar)[XB_TMO])) break; if (_sp > XB_SPIN_CAP) { atomicAdd(&(bar)[XB_TMO], 1u); break; } } } } while (0)
struct XcdBarrier { unsigned* bar; unsigned x; volatile LAS unsigned* st; };
__device__ __forceinline__ XcdBarrier xcd_barrier_post(unsigned* bar, volatile LAS unsigned* st) {
  XcdBarrier b; b.bar = bar; b.x = xb_xcc_id(); b.st = st;
  if (threadIdx.x == 0) (void)xb_add(&bar[XB_XCNT(b.x)], 1u);
  return b;
}
__device__ __forceinline__ void xcd_barrier_complete(unsigned* bar, unsigned x, unsigned& nloc, unsigned& nx) {
  const unsigned G = gridDim.x * gridDim.y * gridDim.z;
  unsigned sum, cnt, mine, sp = 0u;
  for (;;) {
    sum = 0u; cnt = 0u; mine = 0u;
#pragma unroll
    for (unsigned j = 0; j < 16; ++j) { const unsigned c = xb_ld(&bar[XB_XCNT(j)]); sum += c; cnt += (c > 0u) ? 1u : 0u; mine = (j == x) ? c : mine; }
    if (sum == G) break;
    __builtin_amdgcn_s_sleep(1);
    if ((++sp & 255u) == 0u) { if (xb_ld(&bar[XB_TMO])) break; if (sp > XB_SPIN_CAP) { atomicAdd(&bar[XB_TMO], 1u); break; } }
  }
  nloc = mine > 0u ? mine : 1u; nx = cnt > 0u ? cnt : 1u;
}
__device__ __forceinline__ void xcd_barrier(const XcdBarrier& b) {
  asm volatile("s_waitcnt vmcnt(0)" ::: "memory");
  __syncthreads();
  if (threadIdx.x == 0) {
    unsigned* bar = b.bar;
    __builtin_amdgcn_s_waitcnt(0);
    unsigned nloc = b.st[0], nx = b.st[1];
    if (nloc == 0u) { xcd_barrier_complete(bar, b.x, nloc, nx); b.st[0] = nloc; b.st[1] = nx; }
    const unsigned old = xb_add(&bar[XB_XSUB(b.x)], 1u);
    const unsigned gen = old / nloc;
    if (old + 1u == (gen + 1u) * nloc) {
      __builtin_amdgcn_fence(__ATOMIC_RELEASE, "agent");
      asm volatile("s_waitcnt vmcnt(0)" ::: "memory");
      const unsigned og = xb_add(&bar[XB_TOP], 1u);
      const unsigned tg = og / nx;
      if (og + 1u == (tg + 1u) * nx) xb_add(&bar[XB_TOPGEN], 1u);
      else XB_SPIN(xb_ld(&bar[XB_TOPGEN]) == tg, bar);
      __builtin_amdgcn_fence(__ATOMIC_ACQUIRE, "agent");
      xb_add(&bar[XB_XGEN(b.x)], 1u);
      asm volatile("s_waitcnt vmcnt(0)" ::: "memory");
    } else {
      XB_SPIN(xb_ld(&bar[XB_XGEN(b.x)]) == gen, bar);
      __builtin_amdgcn_fence(__ATOMIC_ACQUIRE, "agent");
      asm volatile("s_waitcnt vmcnt(0)" ::: "memory");
    }
  }
  __syncthreads();
}

#ifndef PROBE
#define PROBE 0
#endif
#define PH(id, l) ((id) | ((l) << 4))
#define PHA(id, l, arg) ((id) | ((l) << 4) | ((arg) << 5))
#define LAYER(l) PH(1, l), PH(2, l), PH(4, l), PH(5, l), PH(7, l), PH(8, l), PH(9, l)
__device__ const int PROG[] = {
#if PROBE == 0 || (PROBE >= 10 && PROBE <= 12)
  LAYER(0), LAYER(1), PH(10, 0)
#elif PROBE == 1
  PH(1, 0), LAYER(0), PH(1, 1), LAYER(1), PH(10, 0)
#elif PROBE == 2
  PH(1, 0), PH(2, 0), PH(2, 0), PH(4, 0), PH(5, 0), PH(7, 0), PH(8, 0), PH(9, 0), PH(1, 1), PH(2, 1), PH(2, 1), PH(4, 1), PH(5, 1), PH(7, 1), PH(8, 1), PH(9, 1), PH(10, 0)
#elif PROBE == 4
  PH(1, 0), PH(2, 0), PH(4, 0), PH(4, 0), PH(5, 0), PH(7, 0), PH(8, 0), PH(9, 0), PH(1, 1), PH(2, 1), PH(4, 1), PH(4, 1), PH(5, 1), PH(7, 1), PH(8, 1), PH(9, 1), PH(10, 0)
#elif PROBE == 5
  PH(1, 0), PH(2, 0), PH(4, 0), PH(5, 0), PH(2, 0), PH(4, 0), PHA(5, 0, 0) | (1 << 9), PH(7, 0), PH(8, 0), PH(9, 0), PH(1, 1), PH(2, 1), PH(4, 1), PH(5, 1), PH(2, 1), PH(4, 1), PHA(5, 1, 0) | (1 << 9), PH(7, 1), PH(8, 1), PH(9, 1), PH(10, 0)
#elif PROBE >= 40 && PROBE < 56
  PH(1, 0), PH(2, 0), PH(4, 0), PH(5, 0), PHA(7, 0, PROBE - 40), PH(7, 0), PH(8, 0), PH(9, 0), PH(1, 1), PH(2, 1), PH(4, 1), PH(5, 1), PHA(7, 1, PROBE - 40), PH(7, 1), PH(8, 1), PH(9, 1), PH(10, 0)
#elif PROBE == 7
  PH(1, 0), PH(2, 0), PH(4, 0), PH(5, 0), PH(7, 0), PH(7, 0), PH(8, 0), PH(9, 0), PH(1, 1), PH(2, 1), PH(4, 1), PH(5, 1), PH(7, 1), PH(7, 1), PH(8, 1), PH(9, 1), PH(10, 0)
#elif PROBE == 8
  PH(1, 0), PH(2, 0), PH(4, 0), PH(5, 0), PH(7, 0), PH(8, 0), PH(8, 0), PH(9, 0), PH(1, 1), PH(2, 1), PH(4, 1), PH(5, 1), PH(7, 1), PH(8, 1), PH(8, 1), PH(9, 1), PH(10, 0)
#elif PROBE == 9
  PH(1, 0), PH(2, 0), PH(4, 0), PH(5, 0), PH(7, 0), PH(8, 0), PH(9, 0), PH(9, 0), PH(9, 0), LAYER(1), PH(10, 0)
#else
  PH(1, 0), PH(2, 0), PH(4, 0), PH(5, 0), PHA(5, 0, PROBE - 16), PH(7, 0), PH(8, 0), PH(9, 0), PH(1, 1), PH(2, 1), PH(4, 1), PH(5, 1), PHA(5, 1, PROBE - 16), PH(7, 1), PH(8, 1), PH(9, 1), PH(10, 0)
#endif
};
constexpr int N_PROG = sizeof(PROG) / sizeof(int);
constexpr int N_PHASES = 64;
__global__ void __launch_bounds__(NTHR, 2) fwd_kernel(Params P, int p_lo, int p_hi) {
  extern __shared__ __attribute__((aligned(16))) char smem_raw[];
  LAS char* lds = (LAS char*)smem_raw;
#if ONE_LAUNCH
  volatile LAS unsigned* xst = (volatile LAS unsigned*)(lds + LDS_BYTES - 32);
  if (threadIdx.x == 0) { xst[0] = 0u; xst[1] = 0u; }
  __syncthreads();
  (void)xcd_barrier_post((unsigned*)(P.ws + WS_CTRL), xst);
#endif
#define SEAM() do { XcdBarrier xb_; xb_.bar = (unsigned*)(P.ws + WS_CTRL); xb_.x = xb_xcc_id(); xb_.st = (volatile LAS unsigned*)(lds + LDS_BYTES - 32); xcd_barrier(xb_); } while (0)
  { int npro = (PROBE >= 10 && PROBE <= 12) ? 2 : 1; asm volatile("" : "+s"(npro)); for (int r = 0; r < npro; ++r) { phase_prologue(P, lds, (r == 0 || PROBE == 10) ? 3 : PROBE - 10); if (r + 1 < npro) SEAM(); } }
  if (P.ws == nullptr) cg::this_grid().sync(); else SEAM();
  for (int i = 0; i < N_PROG; ++i) {
    const int code = PROG[i], id = code & 15, l = (code >> 4) & 1, arg = (code >> 5) & 15, second = code >> 9;
    switch (id) {
      case 1: phase_norm(P, l); break;
      case 2: phase_gemm1(P, l, lds); break;
      case 4: phase_gemm2(P, l, lds); break;
      case 5: phase_mix(P, l, (arg || second) ? 2 : 0, arg, lds); break;
      case 7: phase_branch(P, l, lds, 512, arg); break;
      case 8: phase_merge(P, l, lds); break;
      case 9: phase_out(P, l, lds); break;
      default: phase_final(P); break;
    }
    if (i + 1 < N_PROG) SEAM();
  }
}

extern "C" void kernel_launch(void* const* d_in, const int* in_sizes, int n_in, void* d_out, int out_size, void* d_ws, size_t ws_size, hipStream_t stream) {
  static int grid = 0;
  if (grid == 0) {
    if (n_in != 39 || ws_size < WS_END) { fprintf(stderr, "kernel_launch: need 39 inputs and %zu bytes of workspace (got %d, %zu)\n", (size_t)WS_END, n_in, ws_size); grid = -1; return; }
    int dev = 0, cus = 0;
    hipGetDevice(&dev);
    hipDeviceGetAttribute(&cus, hipDeviceAttributeMultiprocessorCount, dev);
    hipFuncSetAttribute((const void*)fwd_kernel, hipFuncAttributeMaxDynamicSharedMemorySize, LDS_BYTES);
    int per_cu = 0;
    hipOccupancyMaxActiveBlocksPerMultiprocessor(&per_cu, (const void*)fwd_kernel, NTHR, LDS_BYTES);
    (void)hipGetLastError();
    if (per_cu < 1) { fprintf(stderr, "kernel_launch: occupancy query says %d blocks per CU\n", per_cu); grid = -1; return; }
    grid = cus;
  }
  if (grid < 0) return;
  Params p{};
  for (int i = 0; i < 39; ++i) p.in[i] = (const float*)d_in[i];
  p.out = (float*)d_out; p.ws = (char*)d_ws;
  hipMemsetAsync(d_ws, 0, 65536, stream);
#if ONE_LAUNCH
  int lo = 0, hi = N_PHASES;
  void* args[] = {&p, &lo, &hi};
  hipError_t e = hipLaunchCooperativeKernel((const void*)fwd_kernel, dim3(grid), dim3(NTHR), args, LDS_BYTES, stream);
  if (e != hipSuccess) fprintf(stderr, "cooperative launch failed: %s\n", hipGetErrorString(e));
#else
  for (int ph = 0; ph < N_PHASES; ++ph) fwd_kernel<<<dim3(grid), dim3(NTHR), LDS_BYTES, stream>>>(p, ph, ph + 1);
#endif
}
```

```cpp
#include <hip/hip_runtime.h>
#include <hip/hip_cooperative_groups.h>
#include <cstdint>
#include <cstdio>
#include <utility>
namespace cg = cooperative_groups;
template <class F, int... I> __device__ __forceinline__ void static_for_(F&& f, std::integer_sequence<int, I...>) { (f(std::integral_constant<int, I>{}), ...); }
template <int N, class F> __device__ __forceinline__ void static_for(F&& f) { static_for_(f, std::make_integer_sequence<int, N>{}); }

#ifndef ONE_LAUNCH
#define ONE_LAUNCH 1
#endif

#define LAS __attribute__((address_space(3)))
typedef _Float16 half_t;
typedef _Float16 half8 __attribute__((ext_vector_type(8)));
typedef _Float16 half4 __attribute__((ext_vector_type(4)));
typedef _Float16 half2v __attribute__((ext_vector_type(2)));
typedef float f32x2e __attribute__((ext_vector_type(2)));
typedef float f32x4 __attribute__((ext_vector_type(4)));
typedef float f32x16 __attribute__((ext_vector_type(16)));
typedef short v4i16_t __attribute__((ext_vector_type(4)));
typedef unsigned u32x2 __attribute__((ext_vector_type(2)));

constexpr int DM = 1024, NPT = 8192, NLT = 4096, NTOK = NPT + NLT, NKEY = 8192 + 2 * 2560;
constexpr int LSEQ = 2048, PSEQ = 256, LKEYS = 2560, PAST = 512;
constexpr int D_IN = 9376, NW1 = 9472;
constexpr int P1COLS = 3328;
constexpr int P1W = 3392;
constexpr int SGW = 2112, HP = 1088, KVP = 1088, YP = 576, MGP = 1088, QAP = 832;
constexpr int WINP = 1088, WOUTP = 1088, WBRP = 576, WGLUP = 576, WQBP = 320, WKVBP = 320;
constexpr float EPS = 1e-6f;
constexpr float LOG2E = 1.4426950408889634f;
constexpr int C_QA = 0, C_KVA = 256, C_KPE = 384, C_DQ = 512, C_DK = 1024, C_DV = 1536, C_GQ = 2048, C_GK = 2560, C_GV = 2688, C_U = 2816;
constexpr size_t O_Y = 0, O_CKV = 12582912, O_KROPE = 14680064, O_DK = 15204352, O_DV = 23592960, O_GK = 31981568, O_GV = 34078720, O_ST = 36175872;

constexpr size_t al256(size_t x) { return (x + 255) & ~(size_t)255; }
constexpr size_t WS_CTRL = 0;
constexpr size_t WS_MOD = 65536;
constexpr size_t WS_LAM = WS_MOD + al256(2 * 3 * 3072 * 4);
constexpr size_t WS_ROPE64 = WS_LAM + 256;
constexpr size_t WS_ROPE32 = WS_ROPE64 + 2048 * 32 * 2 * 4;
constexpr size_t WS_ABAR = WS_ROPE32 + 2048 * 16 * 2 * 4;
constexpr size_t WS_BM = WS_ABAR + 128 * 64 * 2 * 4;
constexpr size_t WS_BSC = WS_BM + 128 * 128 * 16 * 2;
constexpr size_t WS_CM = WS_BSC + 512;
constexpr size_t WS_WIN = WS_CM + 128 * 16 * 128 * 2;
constexpr size_t WS_WQB = WS_WIN + (size_t)2 * NW1 * WINP * 2;
constexpr size_t WS_WKVB = WS_WQB + (size_t)2 * 768 * WQBP * 2;
constexpr size_t WS_WGLU = WS_WKVB + (size_t)2 * 1024 * WKVBP * 2;
constexpr size_t WS_WBR = WS_WGLU + (size_t)2 * 512 * WGLUP * 2;
constexpr size_t WS_WOUT = WS_WBR + (size_t)2 * 4 * 1024 * WBRP * 2;
constexpr size_t WS_H = WS_WOUT + (size_t)2 * 1024 * WOUTP * 2;
constexpr size_t WS_SG = WS_H + (size_t)NTOK * HP * 2;
constexpr size_t WS_P1 = WS_SG + (size_t)NTOK * SGW * 2;
constexpr size_t WS_QA = WS_P1 + (size_t)NKEY * P1W * 2;
constexpr size_t WS_KVA = WS_QA + (size_t)NTOK * QAP * 2;
constexpr size_t WS_Y = WS_KVA + (size_t)NKEY * KVP * 2;
constexpr size_t WS_HEND = WS_Y + (size_t)NTOK * YP * 2;
constexpr size_t WS_A256 = WS_HEND + (size_t)16 * 2 * 64 * 64 * 2 * 4;
constexpr size_t WS_A128 = WS_A256 + (size_t)128 * 64 * 2 * 4;
constexpr size_t WS_END = WS_A128 + (size_t)128 * 64 * 2 * 4;
constexpr int BROP = 4160;
constexpr size_t WS_BRO = WS_P1;
constexpr size_t WS_MG = WS_BRO + (size_t)NTOK * BROP * 2;
static_assert(WS_MG + (size_t)NTOK * MGP * 2 <= WS_Y, "BRO + MG must fit in the dead P1|QA|KVA region");

constexpr int LDS_BYTES = 147456;
constexpr int NTHR = 512;

struct Params {
  const float* in[39];
  float* out;
  char* ws;
};
enum { I_XP = 0, I_XS, I_CCKV, I_CKROPE, I_CDK, I_CDV, I_CGK, I_CGV, I_STATE, I_C, I_CCTX, I_NORMG, I_WMOD, I_BMOD, I_WIN, I_QNORM, I_WQB, I_KVNORM, I_WKVB,
       I_LQ1, I_LK1, I_LQ2, I_LK2, I_SUBLN, I_GQN, I_GKN, I_ARE, I_AIM, I_LOGDT, I_BRE, I_BIM, I_CRE, I_CIM, I_SSMD, I_GLUW, I_GLUB, I_WBR, I_WOUT, I_FNORM };

__device__ __forceinline__ float wave_sum(float v) {
#pragma unroll
  for (int o = 1; o < 64; o <<= 1) v += __shfl_xor(v, o);
  return v;
}
__device__ __forceinline__ float sigmoidf_(float x) { return __builtin_amdgcn_rcpf(1.0f + __builtin_amdgcn_exp2f(-1.4426950408889634f * x)); }
__device__ __forceinline__ float siluf_(float x) { return x * __builtin_amdgcn_rcpf(1.0f + __builtin_amdgcn_exp2f(-1.4426950408889634f * x)); }
__device__ __forceinline__ float gelu_tanh(float x) {
  const float z = 0.7978845608028654f * (x + 0.044715f * x * x * x);
  return x * __builtin_amdgcn_rcpf(1.0f + __builtin_amdgcn_exp2f(-2.8853900817779268f * z));
}
__device__ __forceinline__ half4 to_half4(f32x4 v) { half4 h; h[0] = (half_t)v[0]; h[1] = (half_t)v[1]; h[2] = (half_t)v[2]; h[3] = (half_t)v[3]; return h; }
__device__ __forceinline__ f32x4 to_f32x4(half4 h) { f32x4 v; v[0] = (float)h[0]; v[1] = (float)h[1]; v[2] = (float)h[2]; v[3] = (float)h[3]; return v; }
__device__ __forceinline__ int tile_keyrow(int rt) {
  if (rt < 32) return rt * 256;
  const int j = rt - 32; return 8192 + (j >> 3) * LKEYS + PAST + (j & 7) * 256;
}
__device__ __forceinline__ int tok_keyrow(int t) {
  if (t < NPT) return t;
  const int j = t - NPT; return 8192 + (j >> 11) * LKEYS + PAST + (j & 2047);
}
__device__ __forceinline__ int tok_modrow(int t) { return t < NPT ? 0 : 1 + ((t - NPT) >> 11); }
__device__ __forceinline__ float swap_add(float v) {
  auto rr = __builtin_amdgcn_permlane32_swap(__float_as_uint(v), __float_as_uint(v), false, false);
  return __uint_as_float(rr[0]) + __uint_as_float(rr[1]);
}
__device__ __forceinline__ float swap_max(float v) {
  auto rr = __builtin_amdgcn_permlane32_swap(__float_as_uint(v), __float_as_uint(v), false, false);
  return fmaxf(__uint_as_float(rr[0]), __uint_as_float(rr[1]));
}

__device__ __forceinline__ int lds_byte(int r, int c) { const int st = (r >> 4) * 2 + (c >> 5), rr = r & 15, cc = c & 31, ob = rr * 64 + cc * 2; return st * 1024 + (ob ^ (((ob >> 9) & 1) << 5)); }
__device__ __forceinline__ void stage_rc(int b, int& R, int& C) { const int st = b / 1024, sb = b % 1024, swz = sb ^ (((sb >> 9) & 1) << 5); R = (st >> 1) * 16 + swz / 64; C = (st & 1) * 32 + (swz % 64) / 2; }
constexpr int HTB = 16384, GSTAGE = 3 * HTB;
#define WAIT_V(n) asm volatile("s_waitcnt vmcnt(" #n ")" ::: "memory")
#define WAIT_L0() asm volatile("s_waitcnt lgkmcnt(0)" ::: "memory")
#define BAR() __builtin_amdgcn_s_barrier()

__device__ __forceinline__ void glds16(const half_t* src, LAS char* dst) {
  __builtin_amdgcn_global_load_lds((const unsigned*)src, (LAS unsigned*)dst, 16, 0, 0);
}

__device__ __forceinline__ int ltid() { int t = threadIdx.x; asm volatile("" : "+v"(t)); return t; }
__device__ __forceinline__ void gemm_prefetch0(const half_t* __restrict__ A, int lda, const half_t* __restrict__ Bt, int ldb, LAS char* lds) {
  const int tid = ltid();
  int R0, C0, R1, C1;
  stage_rc(tid * 16, R0, C0); stage_rc(tid * 16 + 8192, R1, C1);
  const unsigned oa0 = (unsigned)(R0 * lda + C0) * 2u, oa1 = (unsigned)(R1 * lda + C1) * 2u;
  const unsigned ob0 = (unsigned)(R0 * ldb + C0) * 2u, ob1 = (unsigned)(R1 * ldb + C1) * 2u;
  const char* Ab = (const char*)A; const char* Ab1 = Ab + (size_t)128 * lda * 2; const char* Bb = (const char*)Bt;
  LAS char* d_ = lds + tid * 16;
  glds16((const half_t*)(Ab + oa0), d_); glds16((const half_t*)(Ab + oa1), d_ + 8192);
  glds16((const half_t*)(Ab1 + oa0), d_ + HTB); glds16((const half_t*)(Ab1 + oa1), d_ + HTB + 8192);
  glds16((const half_t*)(Bb + ob0), d_ + 2 * HTB); glds16((const half_t*)(Bb + ob1), d_ + 2 * HTB + 8192);
}
__device__ __forceinline__ void gemm_kloop(f32x4 (&acc)[4][4], const half_t* __restrict__ A, int lda, const half_t* __restrict__ Bt, int ldb, int K, LAS char* lds, bool pre = false) {
  const int tid = ltid(), lane = tid & 63, wid = tid >> 6, wr = wid >> 1, wc = wid & 1, fr = lane & 15, fq = lane >> 4;
  int R0, C0, R1, C1;
  stage_rc(tid * 16, R0, C0); stage_rc(tid * 16 + 8192, R1, C1);
  const unsigned oa0 = (unsigned)(R0 * lda + C0) * 2u, oa1 = (unsigned)(R1 * lda + C1) * 2u;
  const unsigned ob0 = (unsigned)(R0 * ldb + C0) * 2u, ob1 = (unsigned)(R1 * ldb + C1) * 2u;
  const char* Ab = (const char*)A; const char* Ab1 = Ab + (size_t)128 * lda * 2; const char* Bb = (const char*)Bt;
  LAS char* d0 = lds + tid * 16;
  const int nt = K >> 6;
  const int aoff0 = (wr >> 1) * HTB + lds_byte((wr & 1) * 64 + fr, fq * 8), boff0 = 2 * HTB + lds_byte(wc * 64 + fr, fq * 8);
#define GSTG(kt, buf) do { LAS char* d_ = d0 + (buf) * GSTAGE; const size_t ko_ = (size_t)(kt) * 128; \
    glds16((const half_t*)(Ab + ko_ + oa0), d_); glds16((const half_t*)(Ab + ko_ + oa1), d_ + 8192); \
    glds16((const half_t*)(Ab1 + ko_ + oa0), d_ + HTB); glds16((const half_t*)(Ab1 + ko_ + oa1), d_ + HTB + 8192); \
    glds16((const half_t*)(Bb + ko_ + ob0), d_ + 2 * HTB); glds16((const half_t*)(Bb + ko_ + ob1), d_ + 2 * HTB + 8192); } while (0)
  if (!pre) GSTG(0, 0);
  for (int t = 0; t < nt; ++t) {
    if (t + 1 < nt) { GSTG(t + 1, (t + 1) & 1); WAIT_V(6); } else { WAIT_V(0); }
    BAR();
    LAS char* base = lds + (t & 1) * GSTAGE;
#pragma unroll
    for (int kk = 0; kk < 2; ++kk) {
      half8 a[4], b[4];
#pragma unroll
      for (int m = 0; m < 4; ++m) { a[m] = *(LAS half8*)(base + aoff0 + m * 2048 + kk * 1024); b[m] = *(LAS half8*)(base + boff0 + m * 2048 + kk * 1024); }
#pragma unroll
      for (int m = 0; m < 4; ++m)
#pragma unroll
        for (int n = 0; n < 4; ++n) acc[m][n] = __builtin_amdgcn_mfma_f32_16x16x32_f16(b[n], a[m], acc[m][n], 0, 0, 0);
    }
    WAIT_L0(); BAR();
  }
#undef GSTG
}
__device__ __forceinline__ void zero_acc(f32x4 (&acc)[4][4]) {
#pragma unroll
  for (int m = 0; m < 4; ++m)
#pragma unroll
    for (int n = 0; n < 4; ++n) acc[m][n] = (f32x4){0.f, 0.f, 0.f, 0.f};
}
#define EPI_COORDS const int tid = ltid(), lane = tid & 63, wid = tid >> 6, wr = wid >> 1, wc = wid & 1, fr = lane & 15, fq = lane >> 4; (void)wr; (void)wc; (void)fr; (void)fq;


constexpr int STG_ROWB = 272;
__device__ __forceinline__ void stage_tile(const f32x4 (&v)[4][4], LAS char* lds) {
  EPI_COORDS
#pragma unroll
  for (int m = 0; m < 4; ++m)
#pragma unroll
    for (int n = 0; n < 4; ++n) *(LAS half4*)(lds + (wr * 64 + m * 16 + fr) * STG_ROWB + (wc * 64 + n * 16 + fq * 4) * 2) = to_half4(v[m][n]);
}
template <class F> __device__ __forceinline__ void drain_tile(LAS char* lds, F f) {
  const int tid = ltid();
  __syncthreads();
#pragma unroll
  for (int i = 0; i < 8; ++i) {
    const int idx = i * 512 + tid, row = idx >> 4, ch = idx & 15;
    const half8 v = *(LAS half8*)(lds + row * STG_ROWB + ch * 16);
    f(row, ch * 8, v);
  }
  __syncthreads();
}


__device__ __forceinline__ int fl_byte(int r, int c) { return (r >> 3) * 1024 + (r & 7) * 128 + ((((c >> 3) ^ (r & 7)) & 7) << 4) + (c & 7) * 2; }
__device__ __forceinline__ void fl_stage_rc(int b, int& R, int& C) { const int st = b >> 10, row = (b >> 7) & 7, ch = (b >> 4) & 7; R = st * 8 + row; C = ((ch ^ row) & 7) * 8; }
__device__ __forceinline__ int perm32(int rho) { const int n = rho >> 4, i = rho & 15; return 8 * (i >> 2) + 4 * n + (i & 3); }
__device__ __forceinline__ void gemm256_kloop(f32x4 (&acc)[2][2][4][2], const half_t* __restrict__ A, int lda, const half_t* __restrict__ Bt, int ldb, int K, LAS char* lds,
                                              int bgap = 0, int bhalf = 128, int abl = 0, bool bperm = false) {
  const int tid = ltid(), lane = tid & 63, wid = tid >> 6, wr = wid >> 2, wc = wid & 3, fr = lane & 15, fq = lane >> 4;
  int R0, C0, R1, C1;
  fl_stage_rc(tid * 16, R0, C0); fl_stage_rc(tid * 16 + 8192, R1, C1);
  const unsigned oa0 = (unsigned)(R0 * lda + C0) * 2u, oa1 = (unsigned)(R1 * lda + C1) * 2u;
  const int Rp0 = bperm ? ((R0 & ~31) + perm32(R0 & 31)) : R0, Rp1 = bperm ? ((R1 & ~31) + perm32(R1 & 31)) : R1;
  const unsigned ob0 = (unsigned)((Rp0 + (Rp0 >> 6) * bgap) * ldb + C0) * 2u, ob1 = (unsigned)((Rp1 + (Rp1 >> 6) * bgap) * ldb + C1) * 2u;
  const char* Ab0 = (const char*)A; const char* Ab1 = Ab0 + (size_t)128 * lda * 2;
  const char* Bb0 = (const char*)Bt; const char* Bb1 = Bb0 + (size_t)bhalf * ldb * 2;
  LAS char* d0 = lds + tid * 16;
  const int nt = K >> 6;
  const int aoff = fl_byte(wr * 64 + fr, fq * 8), boff = fl_byte(wc * 32 + fr, fq * 8);
#define G_SA(b, h) (((b) * 2 + (h)) * HTB)
#define G_SB(b, h) ((4 + (b) * 2 + (h)) * HTB)
#define G_STAGE_A(b, h, kt) do { if (abl & 4) break; const char* s_ = ((h) ? Ab1 : Ab0) + (size_t)(kt) * 128; LAS char* d_ = d0 + G_SA(b, h); glds16((const half_t*)(s_ + oa0), d_); glds16((const half_t*)(s_ + oa1), d_ + 8192); } while (0)
#define G_STAGE_B(b, h, kt) do { if (abl & 4) break; const char* s_ = ((h) ? Bb1 : Bb0) + (size_t)(kt) * 128; LAS char* d_ = d0 + G_SB(b, h); glds16((const half_t*)(s_ + ob0), d_); glds16((const half_t*)(s_ + ob1), d_ + 8192); } while (0)
#define G_LDA(dst, b, h) do { if (abl & 2) break; _Pragma("unroll") for (int m = 0; m < 4; ++m) _Pragma("unroll") for (int k = 0; k < 2; ++k) dst[m][k] = *(LAS half8*)(lds + G_SA(b, h) + ((aoff + m * 2048) ^ (k * 64))); } while (0)
#define G_LDB(dst, b, h) do { if (abl & 2) break; _Pragma("unroll") for (int n = 0; n < 2; ++n) _Pragma("unroll") for (int k = 0; k < 2; ++k) dst[n][k] = *(LAS half8*)(lds + G_SB(b, h) + ((boff + n * 2048) ^ (k * 64))); } while (0)
#define G_MMA(ai, bj, At_, Bt_) do { if (abl & 1) break; __builtin_amdgcn_s_setprio(1); _Pragma("unroll") for (int m = 0; m < 4; ++m) _Pragma("unroll") for (int n = 0; n < 2; ++n) _Pragma("unroll") for (int k = 0; k < 2; ++k) \
    acc[ai][bj][m][n] = __builtin_amdgcn_mfma_f32_16x16x32_f16(Bt_[n][k], At_[m][k], acc[ai][bj][m][n], 0, 0, 0); __builtin_amdgcn_s_setprio(0); } while (0)
#define G_WAIT_L(n) asm volatile("s_waitcnt lgkmcnt(" #n ")" ::: "memory")
#define G_SCHED __builtin_amdgcn_sched_barrier(0)
  half8 At[4][2], B0[2][2], B1[2][2];
  G_STAGE_B(0, 0, 0); G_STAGE_B(0, 1, 0); G_STAGE_A(0, 0, 0); G_STAGE_A(0, 1, 0);
  if (wr == 1) BAR();
  WAIT_V(2); BAR();
  G_STAGE_B(1, 0, 1); G_STAGE_A(1, 0, 1); G_STAGE_B(1, 1, 1);
  WAIT_V(6); BAR();
  asm volatile(".p2align 8" ::: "memory");
  for (int t = 0; t < nt; t += 2) {
    const bool last = (t == nt - 2);
    const int t2 = last ? 0 : t + 2, t3 = t2 + 1;
    G_LDB(B0, 0, 0); G_LDB(B1, 0, 1); G_SCHED; G_LDA(At, 0, 0); G_STAGE_A(1, 1, t + 1);
    WAIT_V(8); G_WAIT_L(0); BAR(); G_MMA(0, 0, At, B0); G_MMA(0, 1, At, B1); BAR(); G_SCHED;
    G_LDA(At, 0, 1); G_STAGE_B(0, 0, t2); G_STAGE_B(0, 1, t2); G_STAGE_A(0, 0, t2);
    WAIT_V(8); G_WAIT_L(0); BAR(); G_MMA(1, 0, At, B0); G_MMA(1, 1, At, B1); BAR(); G_SCHED;
    G_LDB(B0, 1, 0); G_LDB(B1, 1, 1); G_SCHED; G_LDA(At, 1, 0); G_STAGE_A(0, 1, t2);
    WAIT_V(8); G_WAIT_L(0); BAR(); G_MMA(0, 0, At, B0); G_MMA(0, 1, At, B1); BAR(); G_SCHED;
    G_LDA(At, 1, 1); G_STAGE_B(1, 0, t3); G_STAGE_B(1, 1, t3); G_STAGE_A(1, 0, t3);
    WAIT_V(8); G_WAIT_L(0); BAR(); G_MMA(1, 0, At, B0); G_MMA(1, 1, At, B1); BAR(); G_SCHED;
  }
  WAIT_V(0);
  if (wr == 0) BAR();
  BAR();
#undef G_SA
#undef G_SB
#undef G_STAGE_A
#undef G_STAGE_B
#undef G_LDA
#undef G_LDB
#undef G_MMA
#undef G_WAIT_L
#undef G_SCHED
}
__device__ __forceinline__ void zero_acc256(f32x4 (&acc)[2][2][4][2]) {
#pragma unroll
  for (int a = 0; a < 2; ++a)
#pragma unroll
    for (int b = 0; b < 2; ++b)
#pragma unroll
      for (int m = 0; m < 4; ++m)
#pragma unroll
        for (int n = 0; n < 2; ++n) acc[a][b][m][n] = (f32x4){0.f, 0.f, 0.f, 0.f};
}
template <int E, bool PERM, class TileF, class EpiF>
__device__ __forceinline__ void gemm256_stream(TileF tilef, int lda, int ldb, int K, LAS char* lds, EpiF epi) {
  const int tid = ltid(), lane = tid & 63, wid = tid >> 6, wr = wid >> 2, wc = wid & 3, fr = lane & 15, fq = lane >> 4;
  int R0, C0, R1, C1;
  fl_stage_rc(tid * 16, R0, C0); fl_stage_rc(tid * 16 + 8192, R1, C1);
  const int Rb0 = PERM ? ((R0 & ~31) + perm32(R0 & 31)) : R0, Rb1 = PERM ? ((R1 & ~31) + perm32(R1 & 31)) : R1;
  const unsigned oa0 = (unsigned)(R0 * lda + C0) * 2u, oa1 = (unsigned)(R1 * lda + C1) * 2u;
  const unsigned ob0 = (unsigned)(Rb0 * ldb + C0) * 2u, ob1 = (unsigned)(Rb1 * ldb + C1) * 2u;
  const size_t ahalf = (size_t)128 * lda * 2, bhalf = (size_t)128 * ldb * 2;
  LAS char* d0 = lds + tid * 16;
  const int nt = K >> 6;
  const int aoff = fl_byte(wr * 64 + fr, fq * 8), boff = fl_byte(wc * 32 + fr, fq * 8);
#define G_SA(b, h) (((b) * 2 + (h)) * HTB)
#define G_SB(b, h) ((4 + (b) * 2 + (h)) * HTB)
#define S_STAGE_A(b, h, base) do { const char* s_ = (base) + ((h) ? ahalf : (size_t)0); LAS char* d_ = d0 + G_SA(b, h); unsigned o0_ = oa0, o1_ = oa1; asm volatile("" : "+v"(o0_), "+v"(o1_)); glds16((const half_t*)(s_ + o0_), d_); glds16((const half_t*)(s_ + o1_), d_ + 8192); } while (0)
#define S_STAGE_B(b, h, base) do { const char* s_ = (base) + ((h) ? bhalf : (size_t)0); LAS char* d_ = d0 + G_SB(b, h); unsigned o0_ = ob0, o1_ = ob1; asm volatile("" : "+v"(o0_), "+v"(o1_)); glds16((const half_t*)(s_ + o0_), d_); glds16((const half_t*)(s_ + o1_), d_ + 8192); } while (0)
#define G_LDA(dst, b, h) do { _Pragma("unroll") for (int m = 0; m < 4; ++m) _Pragma("unroll") for (int k = 0; k < 2; ++k) dst[m][k] = *(LAS half8*)(lds + G_SA(b, h) + ((aoff + m * 2048) ^ (k * 64))); } while (0)
#define G_LDB(dst, b, h) do { _Pragma("unroll") for (int n = 0; n < 2; ++n) _Pragma("unroll") for (int k = 0; k < 2; ++k) dst[n][k] = *(LAS half8*)(lds + G_SB(b, h) + ((boff + n * 2048) ^ (k * 64))); } while (0)
#define G_MMA(ai, bj, At_, Bt_) do { __builtin_amdgcn_s_setprio(1); _Pragma("unroll") for (int m = 0; m < 4; ++m) _Pragma("unroll") for (int n = 0; n < 2; ++n) _Pragma("unroll") for (int k = 0; k < 2; ++k) \
    acc[ai][bj][m][n] = __builtin_amdgcn_mfma_f32_16x16x32_f16(Bt_[n][k], At_[m][k], acc[ai][bj][m][n], 0, 0, 0); __builtin_amdgcn_s_setprio(0); } while (0)
#define G_WAIT_L(n) asm volatile("s_waitcnt lgkmcnt(" #n ")" ::: "memory")
#define G_SCHED __builtin_amdgcn_sched_barrier(0)
  const half_t* tA; const half_t* tB;
  int i = 0;
  if (!tilef(0, tA, tB)) return;
  const char* cA = (const char*)tA; const char* cB = (const char*)tB;
  f32x4 acc[2][2][4][2]; zero_acc256(acc);
  half8 At[4][2], B0[2][2], B1[2][2];
  S_STAGE_B(0, 0, cB); S_STAGE_B(0, 1, cB); S_STAGE_A(0, 0, cA); S_STAGE_A(0, 1, cA);
  if (wr == 1) BAR();
  WAIT_V(2); BAR();
  S_STAGE_B(1, 0, cB + 128); S_STAGE_A(1, 0, cA + 128); S_STAGE_B(1, 1, cB + 128);
  WAIT_V(6); BAR();
  bool fe = false;
  for (;;) {
    const half_t* nAh; const half_t* nBh;
    const bool has_next = tilef(i + 1, nAh, nBh);
    const char* nA = has_next ? (const char*)nAh : cA; const char* nB = has_next ? (const char*)nBh : cB;
    if (fe) WAIT_V(0);
    asm volatile(".p2align 8" ::: "memory");
    for (int t = 0; t < nt; t += 2) {
      const bool last = (t == nt - 2), f0 = fe && (t == 0);
      const char* a2 = last ? nA : cA + (size_t)(t + 2) * 128; const char* b2 = last ? nB : cB + (size_t)(t + 2) * 128;
      const char* a3 = a2 + 128; const char* b3 = b2 + 128;
      G_LDB(B0, 0, 0); G_LDB(B1, 0, 1); G_SCHED; G_LDA(At, 0, 0); if (!f0) S_STAGE_A(1, 1, cA + (size_t)(t + 1) * 128);
      WAIT_V(8); G_WAIT_L(0); BAR(); G_MMA(0, 0, At, B0); G_MMA(0, 1, At, B1); BAR(); G_SCHED;
      G_LDA(At, 0, 1); S_STAGE_B(0, 0, b2); S_STAGE_B(0, 1, b2); S_STAGE_A(0, 0, a2);
      WAIT_V(8); G_WAIT_L(0); BAR(); G_MMA(1, 0, At, B0); G_MMA(1, 1, At, B1); BAR(); G_SCHED;
      G_LDB(B0, 1, 0); G_LDB(B1, 1, 1); G_SCHED; G_LDA(At, 1, 0); S_STAGE_A(0, 1, a2);
      WAIT_V(8); G_WAIT_L(0); BAR(); G_MMA(0, 0, At, B0); G_MMA(0, 1, At, B1); BAR(); G_SCHED;
      G_LDA(At, 1, 1); S_STAGE_B(1, 0, b3); S_STAGE_B(1, 1, b3); S_STAGE_A(1, 0, a3);
      WAIT_V(8); G_WAIT_L(0); BAR(); G_MMA(1, 0, At, B0); G_MMA(1, 1, At, B1); BAR(); G_SCHED;
    }
    if (!has_next) break;
    S_STAGE_A(1, 1, nA + 128);
    epi(i, acc);
    zero_acc256(acc);
    cA = nA; cB = nB; ++i; fe = true;
  }
  WAIT_V(0);
  if (wr == 0) BAR();
  BAR();
  epi(i, acc);
#undef G_SA
#undef G_SB
#undef S_STAGE_A
#undef S_STAGE_B
#undef G_LDA
#undef G_LDB
#undef G_MMA
#undef G_WAIT_L
#undef G_SCHED
}
template <class F> __device__ __forceinline__ void epi_perm256(const f32x4 (&acc)[2][2][4][2], F f) {
  const int tid = ltid(), lane = tid & 63, wid = tid >> 6, wr = wid >> 2, wc = wid & 3, fr = lane & 15, fq = lane >> 4;
#pragma unroll
  for (int ai = 0; ai < 2; ++ai)
#pragma unroll
    for (int m = 0; m < 4; ++m)
#pragma unroll
      for (int bj = 0; bj < 2; ++bj) {
        const f32x4 a = acc[ai][bj][m][0], b = acc[ai][bj][m][1];
        half8 h; h[0] = (half_t)a[0]; h[1] = (half_t)a[1]; h[2] = (half_t)a[2]; h[3] = (half_t)a[3]; h[4] = (half_t)b[0]; h[5] = (half_t)b[1]; h[6] = (half_t)b[2]; h[7] = (half_t)b[3];
        f(ai * 128 + wr * 64 + m * 16 + fr, bj * 128 + wc * 32 + fq * 8, h);
      }
}
constexpr int TSTR = 528;
__device__ __forceinline__ void stage_full256(const f32x4 (&acc)[2][2][4][2], LAS char* lds) {
  const int tid = ltid(), lane = tid & 63, wid = tid >> 6, wr = wid >> 2, wc = wid & 3, fr = lane & 15, fq = lane >> 4;
#pragma unroll
  for (int ai = 0; ai < 2; ++ai)
#pragma unroll
    for (int bj = 0; bj < 2; ++bj)
#pragma unroll
      for (int m = 0; m < 4; ++m)
#pragma unroll
        for (int n = 0; n < 2; ++n)
          *(LAS half4*)(lds + (ai * 128 + wr * 64 + m * 16 + fr) * TSTR + (bj * 128 + wc * 32 + n * 16 + fq * 4) * 2) = to_half4(acc[ai][bj][m][n]);
}
template <class F> __device__ __forceinline__ void drain_full256(LAS char* lds, F f) {
  const int tid = ltid();
  __syncthreads();
#pragma unroll
  for (int i = 0; i < 16; ++i) {
    const int idx = i * 512 + tid, row = idx >> 5, ch = idx & 31;
    const half8 v = *(LAS half8*)(lds + row * TSTR + ch * 16);
    f(row, ch * 8, v);
  }
  __syncthreads();
}
__device__ __forceinline__ void stage_half256(const f32x4 (&acc)[2][2][4][2], int bj, LAS char* lds) {
  const int tid = ltid(), lane = tid & 63, wid = tid >> 6, wr = wid >> 2, wc = wid & 3, fr = lane & 15, fq = lane >> 4;
#pragma unroll
  for (int ai = 0; ai < 2; ++ai)
#pragma unroll
    for (int m = 0; m < 4; ++m)
#pragma unroll
      for (int n = 0; n < 2; ++n)
        *(LAS half4*)(lds + (ai * 128 + wr * 64 + m * 16 + fr) * STG_ROWB + (wc * 32 + n * 16 + fq * 4) * 2) = to_half4(bj ? acc[ai][1][m][n] : acc[ai][0][m][n]);
}

__device__ __forceinline__ void transpose_tile(const float* __restrict__ src, int lds_src, int Ksrc, half_t* __restrict__ dst, int dpitch, int n0, int k0, int colshift_mode, LAS char* wlds) {
  LAS float* tile = (LAS float*)wlds;
  const int lane = ltid() & 63;
  const int c4 = (lane & 15) * 4, kr = lane >> 4;
  const int n = n0 + c4;
  int col = n; bool cvalid = true;
  if (colshift_mode == 1) { if (n >= 416 && n < 512) cvalid = false; else if (n >= 512) col = n - 96; }
  const float wscale = (colshift_mode == 1 && n0 >= 5376) ? -1.4426950408889634f : 1.0f;
  f32x4 v[16];
#pragma unroll
  for (int i = 0; i < 16; ++i) {
    const int kk = kr + i * 4;
    v[i] = (f32x4){0.f, 0.f, 0.f, 0.f};
    if (cvalid && (k0 + kk) < Ksrc) v[i] = *(const f32x4*)(src + (size_t)(k0 + kk) * lds_src + col);
  }
#pragma unroll
  for (int i = 0; i < 16; ++i) {
    const int kk = kr + i * 4;
    tile[kk * 65 + c4 + 0] = v[i][0]; tile[kk * 65 + c4 + 1] = v[i][1]; tile[kk * 65 + c4 + 2] = v[i][2]; tile[kk * 65 + c4 + 3] = v[i][3];
  }
  __builtin_amdgcn_fence(__ATOMIC_RELEASE, "wavefront"); __builtin_amdgcn_wave_barrier(); __builtin_amdgcn_fence(__ATOMIC_ACQUIRE, "wavefront");
  const int kc = (lane & 7) * 8;
#pragma unroll
  for (int i = 0; i < 8; ++i) {
    const int nn = (lane >> 3) + i * 8;
    half8 h;
#pragma unroll
    for (int j = 0; j < 8; ++j) h[j] = (half_t)(tile[(kc + j) * 65 + nn] * wscale);
    *(half8*)(dst + (size_t)(n0 + nn) * dpitch + k0 + kc) = h;
  }
  __builtin_amdgcn_fence(__ATOMIC_RELEASE, "wavefront"); __builtin_amdgcn_wave_barrier(); __builtin_amdgcn_fence(__ATOMIC_ACQUIRE, "wavefront");
}

constexpr int T_WIN = (NW1 / 64) * 16, T_WQB = 12 * 4, T_WKVB = 16 * 4, T_WGLU = 8 * 8, T_WBR = 4 * 16 * 8, T_WOUT = 16 * 16;
constexpr int T_LAYER = T_WIN + T_WQB + T_WKVB + T_WGLU + T_WBR + T_WOUT;
static_assert(T_LAYER % 8 == 0, "eight tiles (one per wave) per workgroup unit");
__device__ __forceinline__ void transpose_unit(const Params& P, int l, int r, LAS char* wl) {
  char* ws = P.ws;
  const float* src; int lds_src, Ksrc, dpitch, n0, k0, cmode = 0; half_t* dst;
  if (r < T_WIN) { src = P.in[I_WIN] + (size_t)l * 1024 * D_IN; lds_src = D_IN; Ksrc = 1024; dst = (half_t*)(ws + WS_WIN) + (size_t)l * NW1 * WINP; dpitch = WINP; n0 = (r >> 4) * 64; k0 = (r & 15) * 64; cmode = 1; }
  else if ((r -= T_WIN) < T_WQB) { src = P.in[I_WQB] + (size_t)l * 256 * 768; lds_src = 768; Ksrc = 256; dst = (half_t*)(ws + WS_WQB) + (size_t)l * 768 * WQBP; dpitch = WQBP; n0 = (r >> 2) * 64; k0 = (r & 3) * 64; }
  else if ((r -= T_WQB) < T_WKVB) { src = P.in[I_WKVB] + (size_t)l * 128 * 1024; lds_src = 1024; Ksrc = 128; dst = (half_t*)(ws + WS_WKVB) + (size_t)l * 1024 * WKVBP; dpitch = WKVBP; n0 = (r >> 2) * 64; k0 = (r & 3) * 64; }
  else if ((r -= T_WKVB) < T_WGLU) { src = P.in[I_GLUW] + (size_t)l * 512 * 512; lds_src = 512; Ksrc = 512; dst = (half_t*)(ws + WS_WGLU) + (size_t)l * 512 * WGLUP; dpitch = WGLUP; n0 = (r >> 3) * 64; k0 = (r & 7) * 64; }
  else if ((r -= T_WGLU) < T_WBR) { const int n = r / 128, rr = r % 128; src = P.in[I_WBR] + ((size_t)l * 4 + n) * 512 * 1024; lds_src = 1024; Ksrc = 512; dst = (half_t*)(ws + WS_WBR) + ((size_t)l * 4 + n) * 1024 * WBRP; dpitch = WBRP; n0 = (rr >> 3) * 64; k0 = (rr & 7) * 64; }
  else { r -= T_WBR; src = P.in[I_WOUT] + (size_t)l * 1024 * 1024; lds_src = 1024; Ksrc = 1024; dst = (half_t*)(ws + WS_WOUT) + (size_t)l * 1024 * WOUTP; dpitch = WOUTP; n0 = (r >> 4) * 64; k0 = (r & 15) * 64; }
  transpose_tile(src, lds_src, Ksrc, dst, dpitch, n0, k0, cmode, wl);
}
__device__ void phase_prologue(const Params& P, LAS char* lds, int what = 3) {
  const int tid = ltid();
  char* ws = P.ws;
  constexpr int U_TR = T_LAYER, U_MOD = 192, U_SSM = 16, U_ROPE = 192;
  constexpr int U_ALL = U_TR + U_MOD + U_SSM + U_ROPE;
  const int nbw = (int)gridDim.x - 16;
  if (what & 1)
  for (int u = (blockIdx.x < 16) ? (U_MOD + (int)blockIdx.x) : ((int)blockIdx.x - 16); u < U_MOD + U_SSM + U_ROPE; u += nbw) {
    int v = u;
    if (blockIdx.x >= 16 && v >= U_MOD) v += U_SSM;
    if (v >= U_MOD + U_SSM + U_ROPE) break;
    if (v < U_MOD) {
      const int l = v / 96, n0 = (v % 96) * 32;
      const int nn = tid & 31, ks = tid >> 5;
      const float* w = P.in[I_WMOD] + (size_t)l * 1024 * 3072 + n0 + nn;
      float s0 = 0.f, s1 = 0.f, s2 = 0.f;
      for (int k = ks * 64; k < ks * 64 + 64; ++k) {
        const float wv = w[(size_t)k * 3072];
        s0 += siluf_(P.in[I_CCTX][k]) * wv; s1 += siluf_(P.in[I_C][k]) * wv; s2 += siluf_(P.in[I_C][1024 + k]) * wv;
      }
      LAS float* red = (LAS float*)lds;
      red[(0 * 16 + ks) * 32 + nn] = s0; red[(1 * 16 + ks) * 32 + nn] = s1; red[(2 * 16 + ks) * 32 + nn] = s2;
      __syncthreads();
      if (tid < 96) {
        const int r = tid >> 5, n = tid & 31; float s = 0.f;
        for (int k = 0; k < 16; ++k) s += red[(r * 16 + k) * 32 + n];
        ((float*)(ws + WS_MOD))[((size_t)l * 3 + r) * 3072 + n0 + n] = s + P.in[I_BMOD][(size_t)l * 3072 + n0 + n];
      }
      asm volatile("s_waitcnt vmcnt(0)" ::: "memory");
      __syncthreads();
      if (l == 0 && tid == 0) {
        __builtin_amdgcn_fence(__ATOMIC_RELEASE, "agent");
        asm volatile("s_waitcnt vmcnt(0)" ::: "memory");
        __hip_atomic_fetch_add((unsigned*)(ws + WS_CTRL) + 12288, 1u, __ATOMIC_RELAXED, __HIP_MEMORY_SCOPE_AGENT);
      }
      continue;
    }
    v -= U_MOD;
    if (v < U_SSM) {
      const int e = v * 512 + tid;
      const int p = e & 63, idx = e >> 6;
      const double are = P.in[I_ARE][e], aim = P.in[I_AIM][e];
      const double dt = exp((double)P.in[I_LOGDT][idx]);
      const double mag = exp(are * dt), ang = aim * dt;
      const double abr = mag * cos(ang), abi = mag * sin(ang);
      const double nr = abr - 1.0, ni = abi, den = are * are + aim * aim;
      const double cr = (nr * are + ni * aim) / den, ci = (ni * are - nr * aim) / den;
      float* ab = (float*)(ws + WS_ABAR); ab[e * 2] = (float)abr; ab[e * 2 + 1] = (float)abi;
      { const double m256 = exp(256.0 * are * dt), a256 = 256.0 * ang; float* a2 = (float*)(ws + WS_A256); a2[e * 2] = (float)(m256 * cos(a256)); a2[e * 2 + 1] = (float)(m256 * sin(a256)); }
      { const double m128 = exp(128.0 * are * dt), a128 = 128.0 * ang; float* a1 = (float*)(ws + WS_A128); a1[e * 2] = (float)(m128 * cos(a128)); a1[e * 2 + 1] = (float)(m128 * sin(a128)); }
      const float sc = exp2f(ceilf(-log2f((float)dt)));
      if (p == 0) ((float*)(ws + WS_BSC))[idx] = 1.0f / sc;
      half_t* bm = (half_t*)(ws + WS_BM) + (size_t)idx * 2048;
      half_t* cm = (half_t*)(ws + WS_CM) + (size_t)idx * 2048;
      f32x4 brv[4], biv[4]; float crv[16], civ[16];
#pragma unroll
      for (int q = 0; q < 4; ++q) { brv[q] = *(const f32x4*)(P.in[I_BRE] + (size_t)e * 16 + q * 4); biv[q] = *(const f32x4*)(P.in[I_BIM] + (size_t)e * 16 + q * 4); }
#pragma unroll
      for (int n = 0; n < 16; ++n) { crv[n] = P.in[I_CRE][((size_t)idx * 16 + n) * 64 + p]; civ[n] = P.in[I_CIM][((size_t)idx * 16 + n) * 64 + p]; }
      half8 b0[2], b1[2];
#pragma unroll
      for (int n = 0; n < 16; ++n) {
        const double br = brv[n >> 2][n & 3], bi = biv[n >> 2][n & 3];
        b0[n >> 3][n & 7] = (half_t)(float)((cr * br - ci * bi) * sc);
        b1[n >> 3][n & 7] = (half_t)(float)((cr * bi + ci * br) * sc);
        cm[n * 128 + 2 * p] = (half_t)crv[n];
        cm[n * 128 + 2 * p + 1] = (half_t)(-civ[n]);
      }
      *(half8*)(bm + (2 * p) * 16) = b0[0]; *(half8*)(bm + (2 * p) * 16 + 8) = b0[1];
      *(half8*)(bm + (2 * p + 1) * 16) = b1[0]; *(half8*)(bm + (2 * p + 1) * 16 + 8) = b1[1];
      if (v == 0 && tid < 2) {
        const int l = tid; float a = 0.f, b = 0.f;
        for (int i = 0; i < 64; ++i) { a += P.in[I_LQ1][l * 64 + i] * P.in[I_LK1][l * 64 + i]; b += P.in[I_LQ2][l * 64 + i] * P.in[I_LK2][l * 64 + i]; }
        const float lam_init = 0.8f - 0.6f * expf(-0.3f * (float)l);
        ((float*)(ws + WS_LAM))[l] = expf(a) - expf(b) + lam_init;
      }
      continue;
    }
    v -= U_SSM;
    {
      const int e = v * 512 + tid;
      const int s = e / 48, j = e % 48;
      const float row = (float)(s >> 6), col = (float)(s & 63);
      if (j < 32) {
        const int q = j & 15; const float inv = powf(10000.0f, -(float)q / 16.0f);
        const float ang = (j < 16 ? row : col) * inv; float sn, cs; sincosf(ang, &sn, &cs);
        float* t = (float*)(ws + WS_ROPE64) + ((size_t)s * 32 + j) * 2; t[0] = cs; t[1] = sn;
      } else {
        const int jj = j - 32, q = jj & 7; const float inv = powf(10000.0f, -(float)q / 8.0f);
        const float ang = (jj < 8 ? row : col) * inv; float sn, cs; sincosf(ang, &sn, &cs);
        float* t = (float*)(ws + WS_ROPE32) + ((size_t)s * 16 + jj) * 2; t[0] = cs; t[1] = sn;
      }
    }
  }
  __syncthreads();
  if (blockIdx.x >= 16 && (what & 2)) {
    LAS char* wl = lds + (tid >> 6) * (64 * 65 * 4);
    for (int u = (tid >> 6) * nbw + ((int)blockIdx.x - 16); u < U_TR; u += 8 * nbw) transpose_unit(P, 0, u, wl);
  }
}

__device__ __forceinline__ const float* xin_row(const Params& P, int row) {
  return row < NPT ? P.in[I_XP] + (size_t)row * DM : P.in[I_XS] + (size_t)(row - NPT) * DM;
}
__device__ __forceinline__ half_t* x1_row(const Params& P, int row) { return (half_t*)P.out + (size_t)row * DM; }
__device__ __forceinline__ half_t* x2_row(const Params& P, int row) { return (half_t*)(P.ws + WS_H) + (size_t)row * HP; }
__device__ void phase_norm(const Params& P, int l) {
  const int tid_ = ltid(), lane = tid_ & 63, wid = tid_ >> 6;
  const float* g = P.in[I_NORMG] + l * DM;
  const int nw = (int)gridDim.x * 8, per = (NTOK + nw - 1) / nw;
  const int row0 = ((int)blockIdx.x * 8 + wid) * per, row1 = (row0 + per < NTOK) ? row0 + per : NTOK;
  f32x4 w[2][2], sh[2][2];
  int cur_mod = -1;
  constexpr int RB = 3;
  for (int rb = row0; rb < row1; rb += RB) {
    f32x4 v[RB][2][2];
#pragma unroll
    for (int q = 0; q < RB; ++q) {
      const int row = (rb + q < row1) ? rb + q : row1 - 1;
      if (l == 0) {
        const float* x = xin_row(P, row);
#pragma unroll
        for (int i = 0; i < 2; ++i) { v[q][i][0] = *(const f32x4*)(x + i * 512 + lane * 8); v[q][i][1] = *(const f32x4*)(x + i * 512 + lane * 8 + 4); }
      } else {
        const half_t* x = x1_row(P, row);
#pragma unroll
        for (int i = 0; i < 2; ++i) { const half8 h = *(const half8*)(x + i * 512 + lane * 8);
#pragma unroll
          for (int j = 0; j < 4; ++j) { v[q][i][0][j] = (float)h[j]; v[q][i][1][j] = (float)h[4 + j]; } }
      }
    }
    __builtin_amdgcn_sched_barrier(0);
#pragma unroll
    for (int q = 0; q < RB; ++q) {
      const int row = rb + q;
      if (row >= row1) break;
      const int mr = tok_modrow(row);
      if (mr != cur_mod) {
        cur_mod = mr;
        const float* mod = (const float*)(P.ws + WS_MOD) + ((size_t)l * 3 + mr) * 3072;
#pragma unroll
        for (int i = 0; i < 2; ++i)
#pragma unroll
          for (int k = 0; k < 2; ++k) {
            const int c = i * 512 + lane * 8 + k * 4;
            const f32x4 gg = *(const f32x4*)(g + c), sc = *(const f32x4*)(mod + 1024 + c);
            sh[i][k] = *(const f32x4*)(mod + c);
#pragma unroll
            for (int j = 0; j < 4; ++j) w[i][k][j] = gg[j] * (1.0f + sc[j]);
          }
      }
      float ss = 0.f;
#pragma unroll
      for (int i = 0; i < 2; ++i)
#pragma unroll
        for (int k = 0; k < 2; ++k) ss += v[q][i][k][0] * v[q][i][k][0] + v[q][i][k][1] * v[q][i][k][1] + v[q][i][k][2] * v[q][i][k][2] + v[q][i][k][3] * v[q][i][k][3];
      ss = wave_sum(ss);
      const float rstd = rsqrtf(ss * (1.0f / DM) + EPS);
      half_t* h = (half_t*)(P.ws + WS_H) + (size_t)row * HP;
#pragma unroll
      for (int i = 0; i < 2; ++i) {
        half8 o;
#pragma unroll
        for (int j = 0; j < 4; ++j) { o[j] = (half_t)(v[q][i][0][j] * rstd * w[i][0][j] + sh[i][0][j]); o[4 + j] = (half_t)(v[q][i][1][j] * rstd * w[i][1][j] + sh[i][1][j]); }
        *(half8*)(h + i * 512 + lane * 8) = o;
      }
    }
  }
}
__device__ void phase_final(const Params& P) {
  const int tid_ = ltid(), lane = tid_ & 63, wid = tid_ >> 6;
  const float* g = P.in[I_FNORM];
  const int nw = (int)gridDim.x * 8, per = (NTOK + nw - 1) / nw;
  const int row0 = ((int)blockIdx.x * 8 + wid) * per, row1 = (row0 + per < NTOK) ? row0 + per : NTOK;
  f32x4 gg[2][2];
#pragma unroll
  for (int i = 0; i < 2; ++i) { gg[i][0] = *(const f32x4*)(g + i * 512 + lane * 8); gg[i][1] = *(const f32x4*)(g + i * 512 + lane * 8 + 4); }
  constexpr int RB = 3;
  for (int rb = row0; rb < row1; rb += RB) {
    half8 hv[RB][2];
#pragma unroll
    for (int q = 0; q < RB; ++q) {
      const half_t* x2 = x2_row(P, (rb + q < row1) ? rb + q : row1 - 1);
#pragma unroll
      for (int i = 0; i < 2; ++i) hv[q][i] = *(const half8*)(x2 + i * 512 + lane * 8);
    }
    __builtin_amdgcn_sched_barrier(0);
#pragma unroll
    for (int q = 0; q < RB; ++q) {
      const int row = rb + q;
      if (row >= row1) break;
      float* x = P.out + (size_t)row * DM;
      f32x4 v[2][2]; float ss = 0.f;
#pragma unroll
      for (int i = 0; i < 2; ++i)
#pragma unroll
        for (int j = 0; j < 4; ++j) { v[i][0][j] = (float)hv[q][i][j]; v[i][1][j] = (float)hv[q][i][4 + j]; }
#pragma unroll
      for (int i = 0; i < 2; ++i)
#pragma unroll
        for (int k = 0; k < 2; ++k) ss += v[i][k][0] * v[i][k][0] + v[i][k][1] * v[i][k][1] + v[i][k][2] * v[i][k][2] + v[i][k][3] * v[i][k][3];
      ss = wave_sum(ss);
      const float rstd = rsqrtf(ss * (1.0f / DM) + EPS);
#pragma unroll
      for (int i = 0; i < 2; ++i)
#pragma unroll
        for (int k = 0; k < 2; ++k) {
          f32x4 o;
#pragma unroll
          for (int j = 0; j < 4; ++j) o[j] = v[i][k][j] * rstd * gg[i][k][j];
          *(f32x4*)(x + i * 512 + lane * 8 + k * 4) = o;
        }
    }
  }
}

__device__ __forceinline__ float red16(float v) { v += __shfl_xor(v, 1); v += __shfl_xor(v, 2); v += __shfl_xor(v, 4); v += __shfl_xor(v, 8); return v; }
__device__ void post_tile(const Params& P, int l, int rt, int ct, LAS char* lds) {
  const int tid_ = ltid(), lane = tid_ & 63, wid = tid_ >> 6;
  const bool latent = rt >= 32;
  half_t* P1 = (half_t*)(P.ws + WS_P1) + (size_t)tile_keyrow(rt) * P1W + ct * 256 + lane * 4;
  float* out = P.out;
  const float qs = 0.125f * LOG2E;
  f32x4 gvec = (f32x4){1.f, 1.f, 1.f, 1.f};
  if (ct == 0) gvec = *(const f32x4*)(P.in[I_QNORM] + l * 256 + lane * 4);
  else if (ct == 1) { if (lane < 32) gvec = *(const f32x4*)(P.in[I_KVNORM] + l * 128 + lane * 4); }
  else if (ct == 8 || ct == 9) gvec = *(const f32x4*)(P.in[I_GQN] + l * 64 + (lane & 15) * 4);
  else if (ct == 10) { if (lane < 32) gvec = *(const f32x4*)(P.in[I_GKN] + l * 64 + (lane & 15) * 4); }
  const bool rope64 = latent && ((ct >= 2 && ct <= 5) || ct == 8 || ct == 9 || (ct == 10 && lane < 32));
  const bool rope32 = latent && ct == 1 && lane >= 32 && lane < 40;
  const bool second = (ct == 1) ? (lane >= 36) : ((lane & 8) != 0);
  const int ridx = (ct == 1) ? ((lane & 3) * 4) : ((lane & 7) * 4);
  constexpr int RG = 8;
  const bool anyrope = latent && (ct <= 5 || ct >= 8) && ct <= 10 && ct != 0;
  const float* tbase = rope32 ? (const float*)(P.ws + WS_ROPE32) + ridx * 2 : (const float*)(P.ws + WS_ROPE64) + ridx * 2;
  const int tstride = rope32 ? 32 : 64;
  const int pos0 = latent ? ((rt - 32) & 7) * 256 + wid * 32 : 0;
  f32x4 csA[RG], csB[RG];
  if (anyrope && (rope64 || rope32)) {
#pragma unroll
    for (int q = 0; q < RG; ++q) { const float* tb = tbase + (size_t)(pos0 + q) * tstride; csA[q] = *(const f32x4*)tb; csB[q] = *(const f32x4*)(tb + 4); }
  }
  for (int r0 = 0; r0 < 32; r0 += RG) {
    f32x4 v[RG], cA[RG], cB[RG];
#pragma unroll
    for (int q = 0; q < RG; ++q) { v[q] = to_f32x4(*(LAS half4*)(lds + (wid * 32 + r0 + q) * TSTR + lane * 8)); cA[q] = csA[q]; cB[q] = csB[q]; }
    if (anyrope && (rope64 || rope32) && r0 + RG < 32) {
#pragma unroll
      for (int q = 0; q < RG; ++q) { const float* tb = tbase + (size_t)(pos0 + r0 + RG + q) * tstride; csA[q] = *(const f32x4*)tb; csB[q] = *(const f32x4*)(tb + 4); }
    }
    if (ct == 0 || ct == 1 || ct == 8 || ct == 9 || ct == 10) {
      float ss[RG];
#pragma unroll
      for (int q = 0; q < RG; ++q) { ss[q] = v[q][0] * v[q][0] + v[q][1] * v[q][1] + v[q][2] * v[q][2] + v[q][3] * v[q][3]; if (ct == 1 && lane >= 32) ss[q] = 0.f; }
      if (ct <= 1) {
#pragma unroll
        for (int o = 1; o < 64; o <<= 1)
#pragma unroll
          for (int q = 0; q < RG; ++q) ss[q] += __shfl_xor(ss[q], o);
      } else {
#pragma unroll
        for (int o = 1; o < 16; o <<= 1)
#pragma unroll
          for (int q = 0; q < RG; ++q) ss[q] += __shfl_xor(ss[q], o);
      }
      const float inv_n = (ct == 0) ? (1.0f / 256.0f) : (ct == 1) ? (1.0f / 128.0f) : (1.0f / 64.0f);
      const bool doit = (ct == 0) || (ct == 1 && lane < 32) || ct == 8 || ct == 9 || (ct == 10 && lane < 32);
      if (doit) {
#pragma unroll
        for (int q = 0; q < RG; ++q) { const float rs = rsqrtf(ss[q] * inv_n + EPS); v[q] = v[q] * rs * gvec; }
      }
    }
    if (anyrope) {
      f32x4 pv[RG];
#pragma unroll
      for (int q = 0; q < RG; ++q)
#pragma unroll
        for (int j = 0; j < 4; ++j) pv[q][j] = __shfl_xor(v[q][j], (ct == 1) ? 4 : 8);
      if (rope64 || rope32) {
#pragma unroll
        for (int q = 0; q < RG; ++q) {
          const float c[4] = {cA[q][0], cA[q][2], cB[q][0], cB[q][2]}, sn[4] = {cA[q][1], cA[q][3], cB[q][1], cB[q][3]};
#pragma unroll
          for (int j = 0; j < 4; ++j) v[q][j] = second ? (pv[q][j] * sn[j] + v[q][j] * c[j]) : (v[q][j] * c[j] - pv[q][j] * sn[j]);
        }
      }
    }
    if (ct == 2 || ct == 3 || ct == 8 || ct == 9) {
#pragma unroll
      for (int q = 0; q < RG; ++q) v[q] = v[q] * qs;
    }
#pragma unroll
    for (int q = 0; q < RG; ++q) {
      const int r = wid * 32 + r0 + q;
      *(half4*)(P1 + (size_t)r * P1W) = to_half4(v[q]);
      if (!latent) {
        const size_t sidx = ((size_t)rt * 2 + l) * 256 + r;
        if (ct == 1) { if (lane < 32) *(f32x4*)(out + O_CKV + sidx * 128 + lane * 4) = v[q]; else if (lane < 40) *(f32x4*)(out + O_KROPE + sidx * 32 + (lane - 32) * 4) = v[q]; }
        else if (ct == 4 || ct == 5) *(f32x4*)(out + O_DK + sidx * 512 + (ct - 4) * 256 + lane * 4) = v[q];
        else if (ct == 6 || ct == 7) *(f32x4*)(out + O_DV + sidx * 512 + (ct - 6) * 256 + lane * 4) = v[q];
        else if (ct == 10) { if (lane < 32) *(f32x4*)(out + O_GK + sidx * 128 + lane * 4) = v[q]; else *(f32x4*)(out + O_GV + sidx * 128 + (lane - 32) * 4) = v[q]; }
      }
    }
  }
}

__device__ void phase_gemm1(const Params& P, int l, LAS char* lds) {
  const half_t* H = (const half_t*)(P.ws + WS_H);
  const half_t* W = (const half_t*)(P.ws + WS_WIN) + (size_t)l * NW1 * WINP;
  half_t* SG = (half_t*)(P.ws + WS_SG);
  constexpr int NCT = 21, NU = 48 * NCT, NCACHE = 2 * PAST / 8;
  for (int uu = blockIdx.x; uu < NU + NCACHE; uu += gridDim.x) {
    if (uu >= NU) {
      const int tid_ = ltid(), lane = tid_ & 63, wid = tid_ >> 6;
      const int j = (uu - NU) * 8 + wid, b = j >> 9, s = j & 511;
      half_t* row = (half_t*)(P.ws + WS_P1) + (size_t)(8192 + b * LKEYS + s) * P1W;
      const size_t cb = ((size_t)b * 2 + l) * PAST + s;
      const float* ckv = P.in[I_CCKV] + cb * 128; const float* kro = P.in[I_CKROPE] + cb * 32;
      const float* dk = P.in[I_CDK] + cb * 512;   const float* dv = P.in[I_CDV] + cb * 512;
      const float* gk = P.in[I_CGK] + cb * 128;   const float* gv = P.in[I_CGV] + cb * 128;
      f32x4 a0 = (f32x4){0.f, 0.f, 0.f, 0.f}, a1 = a0, a2 = a0, a3 = a0, d0[2], d1[2];
      if (lane < 32) { a0 = *(const f32x4*)(ckv + lane * 4); a1 = *(const f32x4*)(gk + lane * 4); a2 = *(const f32x4*)(gv + lane * 4); if (lane < 8) a3 = *(const f32x4*)(kro + lane * 4); }
#pragma unroll
      for (int i = 0; i < 2; ++i) { d0[i] = *(const f32x4*)(dk + (i * 64 + lane) * 4); d1[i] = *(const f32x4*)(dv + (i * 64 + lane) * 4); }
      __builtin_amdgcn_sched_barrier(0);
      if (lane < 32) {
        *(half4*)(row + C_KVA + lane * 4) = to_half4(a0);
        *(half4*)(row + C_GK + lane * 4) = to_half4(a1);
        *(half4*)(row + C_GV + lane * 4) = to_half4(a2);
        *(half4*)(row + C_KPE + lane * 4) = to_half4(a3);
      }
#pragma unroll
      for (int i = 0; i < 2; ++i) {
        *(half4*)(row + C_DK + (i * 64 + lane) * 4) = to_half4(d0[i]);
        *(half4*)(row + C_DV + (i * 64 + lane) * 4) = to_half4(d1[i]);
      }
      continue;
    }
    const int u = uu;
    const int ci = u / 48, rt = u % 48;
    const int ct = (ci < 16) ? ((ci & 1) ? 13 + (ci >> 1) : (ci >> 1)) : ci - 8;
    f32x4 acc[2][2][4][2]; zero_acc256(acc);
    gemm256_kloop(acc, H + (size_t)rt * 256 * HP, HP, W + (size_t)ct * 256 * WINP, WINP, 1024, lds);
    if (ct < 13) {
      stage_full256(acc, lds);
      __syncthreads();
      post_tile(P, l, rt, ct, lds);
      __syncthreads();
      continue;
    }
#pragma unroll
    for (int a = 0; a < 2; ++a)
#pragma unroll
      for (int b2 = 0; b2 < 2; ++b2)
#pragma unroll
        for (int m = 0; m < 4; ++m)
#pragma unroll
          for (int n = 0; n < 2; ++n)
#pragma unroll
            for (int j = 0; j < 4; ++j) acc[a][b2][m][n][j] = siluf_(acc[a][b2][m][n][j]);
    half_t* dst = SG + (size_t)rt * 256 * SGW + (ct - 13) * 256;
    stage_full256(acc, lds);
    drain_full256(lds, [&](int row, int c8, half8 v) { *(half8*)(dst + (size_t)row * SGW + c8) = v; });
  }
}

template <bool STATE_ONLY> __device__ void ssm_tile(const Params& P, int l, int rt, int oct, LAS char* lds, int sh = 0);
__device__ void phase_gemm2(const Params& P, int l, LAS char* lds) {
  const half_t* P1 = (const half_t*)(P.ws + WS_P1);
  const half_t* WQ = (const half_t*)(P.ws + WS_WQB) + (size_t)l * 768 * WQBP;
  const half_t* WK = (const half_t*)(P.ws + WS_WKVB) + (size_t)l * 1024 * WKVBP;
  half_t* QA = (half_t*)(P.ws + WS_QA); half_t* KVA = (half_t*)(P.ws + WS_KVA);
  constexpr int NUS = 128, NUQ = 48 * 6, NUK = 52 * 8;
  const float qscale = 0.10206207261596575f * LOG2E;
  const int bx = (int)blockIdx.x, gx = (int)gridDim.x;
  auto unit_of = [&](int it) -> int {
    if (gx == 256) {
      if (bx < 128) return it == 0 ? bx : it == 1 ? NUS + 512 + bx : (it == 2 && bx < 64) ? NUS + 640 + bx : -1;
      return it < 4 ? NUS + (bx - 128) + it * 128 : -1;
    }
    const int uu = bx + it * gx; return uu < NUS + NUQ + NUK ? uu : -1;
  };
  auto tile_ptrs = [&](int uu, const half_t*& A, const half_t*& Bt, int& ldb, int& K) {
    const int u = uu - NUS;
    if (u < NUQ) { const int ct = u / 48, rt = u % 48; A = P1 + (size_t)tile_keyrow(rt) * P1W + C_QA; Bt = WQ + (size_t)ct * 128 * WQBP; ldb = WQBP; K = 256; }
    else { const int v = u - NUQ, ct = v / 52, rt = v % 52; A = P1 + (size_t)rt * 256 * P1W + C_KVA; Bt = WK + (size_t)ct * 128 * WKVBP; ldb = WKVBP; K = 128; }
  };
  LAS char* stg = lds + GSTAGE;
  bool pre = false;
  for (int it = 0; ; ++it) {
    const int uu = unit_of(it);
    if (uu < 0) break;
    if (uu < NUS) { ssm_tile<true>(P, l, 32 + (uu >> 3), (uu >> 1) & 3, lds, uu & 1); __syncthreads(); pre = false; continue; }
    const int u = uu - NUS;
    const half_t* tA; const half_t* tB; int tldb, tK;
    tile_ptrs(uu, tA, tB, tldb, tK);
    f32x4 acc[4][4]; zero_acc(acc);
    gemm_kloop(acc, tA, P1W, tB, tldb, tK, lds, pre);
    {
      const int un = unit_of(it + 1);
      pre = false;
      if (un >= NUS) { const half_t* nA; const half_t* nB; int nldb, nK; tile_ptrs(un, nA, nB, nldb, nK); gemm_prefetch0(nA, P1W, nB, nldb, lds); pre = true; }
    }
    if (u < NUQ) {
      const int ct = u / 48, rt = u % 48;
      {
        EPI_COORDS
        const bool latent = rt >= 32;
        f32x4 rtab[4][2];
        if (latent) {
#pragma unroll
          for (int m = 0; m < 4; ++m) {
            const int r = rt * 256 + wr * 64 + m * 16 + fr;
            const float* r32 = (const float*)(P.ws + WS_ROPE32) + (size_t)((r - NPT) & 2047) * 32 + fq * 8;
            rtab[m][0] = *(const f32x4*)r32; rtab[m][1] = *(const f32x4*)(r32 + 4);
          }
          __builtin_amdgcn_sched_barrier(0);
        }
#pragma unroll
        for (int m = 0; m < 4; ++m) {
#pragma unroll
          for (int np = 0; np < 2; ++np) {
            const int cb = ct * 128 + wc * 64 + np * 32;
            f32x4 v0 = acc[m][np * 2], v1 = acc[m][np * 2 + 1];
            if (latent && (cb % 96) == 64) {
#pragma unroll
              for (int j = 0; j < 4; ++j) { const float c = rtab[m][j >> 1][(j & 1) * 2], s = rtab[m][j >> 1][(j & 1) * 2 + 1];
                const float x1 = v0[j], x2 = v1[j]; v0[j] = x1 * c - x2 * s; v1[j] = x1 * s + x2 * c; }
            }
            acc[m][np * 2] = v0 * qscale; acc[m][np * 2 + 1] = v1 * qscale;
          }
        }
      }
      stage_tile(acc, stg);
      half_t* dst = QA + (size_t)rt * 256 * QAP + ct * 128;
      drain_tile(stg, [&](int row, int c8, half8 v) { *(half8*)(dst + (size_t)row * QAP + c8) = v; });
    } else {
      const int v = u - NUQ, ct = v / 52, rt = v % 52;
      stage_tile(acc, stg);
      half_t* dst = KVA + (size_t)rt * 256 * KVP + ct * 128;
      drain_tile(stg, [&](int row, int c8, half8 vv) { *(half8*)(dst + (size_t)row * KVP + c8) = vv; });
    }
  }
}

__device__ __forceinline__ int crow(int r, int hi) { return (r & 3) + 8 * (r >> 2) + 4 * hi; }
constexpr int KSTR = 64 * 16 + 16;
constexpr int ATT_NST = 3;
template <int NCH1, int NCH2, int DV>
__device__ __forceinline__ void attn_pass(const half_t* __restrict__ Q, int ldq, const half_t* __restrict__ K1, int ldk1, const half_t* __restrict__ K2, int ldk2,
                                          const half_t* __restrict__ V, int ldv, int nkeys, LAS char* lds, f32x16 (&o)[DV / 32], float& linv, int pf = 0) {
  constexpr int NCH = NCH1 + NCH2, ND0 = NCH / 2, NDB = DV / 32;
  constexpr int KSL = ((NCH * KSTR + 255) / 256) * 256, VSL = NDB * 4096, VOFF0 = ATT_NST * KSL;
  constexpr int PKW = (NCH + 7) / 8, PVW = (NDB * 4) / 8;
  const int tid = ltid(), lane = tid & 63, wid = __builtin_amdgcn_readfirstlane(tid >> 6), r32 = lane & 31, hi = lane >> 5;
  half8 qf[ND0];
  {
    const half_t* qp = Q + (size_t)(wid * 32 + r32) * ldq + hi * 8;
#pragma unroll
    for (int d0 = 0; d0 < ND0; ++d0) qf[d0] = *(const half8*)(qp + d0 * 16);
  }
  const half_t* kbase[PKW]; int kld[PKW], kdst[PKW];
  const half_t* vbase[PVW]; int vdst[PVW], vlo[PVW];
#pragma unroll
  for (int i = 0; i < PKW; ++i) {
    int c = wid + 8 * i; if (c >= NCH) c = wid;
    kdst[i] = c * KSTR;
    if (c < NCH1) { kbase[i] = K1 + c * 8; kld[i] = ldk1; } else { kbase[i] = K2 + (c - NCH1) * 8; kld[i] = ldk2; }
  }
#pragma unroll
  for (int i = 0; i < PVW; ++i) {
    const int q = wid + 8 * i, dblk = q >> 2, rg = q & 3;
    vdst[i] = VOFF0 + dblk * 4096 + rg * 1024;
    vbase[i] = V + (size_t)(rg * 16) * ldv + dblk * 32;
    vlo[i] = (lane >> 2) * ldv + (lane & 3) * 8;
  }
  const int nt = nkeys >> 6;
  LAS char* ldl = lds + lane * 16;
#define AT_KDMA(t, sl) do { _Pragma("unroll") for (int i = 0; i < PKW; ++i) glds16(kbase[i] + (size_t)(((t) * 64 + lane) * kld[i]), ldl + (sl) * KSL + kdst[i]); } while (0)
#define AT_VDMA(t, sl) do { _Pragma("unroll") for (int i = 0; i < PVW; ++i) glds16(vbase[i] + (size_t)(t) * 64 * ldv + vlo[i], ldl + (sl) * VSL + vdst[i]); } while (0)
#define AT_VMWAIT(full) do { if (full) { if (PKW + PVW == 2) WAIT_V(2); else if (PKW + PVW == 3) WAIT_V(3); else WAIT_V(4); } else WAIT_V(0); } while (0)
#define AT_NEXT(x) (((x) == ATT_NST - 1) ? 0 : (x) + 1)
  const int la = wid >> 2;
  AT_KDMA(0, 0); AT_KDMA(1, 1); AT_VDMA(0, 0);
  if (la) { AT_KDMA(2, 2); AT_VDMA(1, 1); }
  WAIT_V(0);
  __syncthreads();
  float mrun = 0.f;
  f32x16 negm;
  float lrun = 0.f;
#pragma unroll
  for (int r = 0; r < 16; ++r) negm[r] = 0.f;
  half8 ones;
#pragma unroll
  for (int j = 0; j < 8; ++j) ones[j] = (half_t)1.0f;
#pragma unroll
  for (int d = 0; d < NDB; ++d)
#pragma unroll
    for (int r = 0; r < 16; ++r) o[d][r] = 0.f;
  const int koff = hi * KSTR + r32 * 16;
  const int voff = VOFF0 + (4 * hi + ((lane & 15) >> 2)) * 64 + ((lane >> 4) & 1) * 32 + (lane & 3) * 8;
  half8 pb[4];
  typedef short s16x8 __attribute__((ext_vector_type(8)));
  constexpr int NPV = (NDB / 2) * 4;
  v4i16_t vl_[NPV][2], vh_[NPV][2]; half8 kf_[ND0][2];
  f32x16 p0, p1;
  const unsigned ldsb = (unsigned)(size_t)lds;
  unsigned vfb = 0, kfb = 0;
  auto lds_wait4 = [&](auto nc, auto& A, auto& B, auto& C, auto& D) {
    constexpr int n = decltype(nc)::value;
    if constexpr (n == 0) asm volatile("s_waitcnt lgkmcnt(0)" : "+v"(A), "+v"(B), "+v"(C), "+v"(D));
    else if constexpr (n == 2) asm volatile("s_waitcnt lgkmcnt(2)" : "+v"(A), "+v"(B), "+v"(C), "+v"(D));
    else if constexpr (n == 4) asm volatile("s_waitcnt lgkmcnt(4)" : "+v"(A), "+v"(B), "+v"(C), "+v"(D));
    else if constexpr (n == 6) asm volatile("s_waitcnt lgkmcnt(6)" : "+v"(A), "+v"(B), "+v"(C), "+v"(D));
    else asm volatile("s_waitcnt lgkmcnt(8)" : "+v"(A), "+v"(B), "+v"(C), "+v"(D));
  };
  auto lds_wait2 = [&](auto nc, auto& A, auto& B) {
    constexpr int n = decltype(nc)::value;
    if constexpr (n == 0) asm volatile("s_waitcnt lgkmcnt(0)" : "+v"(A), "+v"(B));
    else if constexpr (n == 2) asm volatile("s_waitcnt lgkmcnt(2)" : "+v"(A), "+v"(B));
    else if constexpr (n == 4) asm volatile("s_waitcnt lgkmcnt(4)" : "+v"(A), "+v"(B));
    else if constexpr (n == 6) asm volatile("s_waitcnt lgkmcnt(6)" : "+v"(A), "+v"(B));
    else asm volatile("s_waitcnt lgkmcnt(8)" : "+v"(A), "+v"(B));
  };
  auto rop = [&vl_, &vh_, &kf_, &vfb, &kfb](auto uc, auto pc) {
    constexpr int u = decltype(uc)::value, PVN = decltype(pc)::value;
    if constexpr (u < PVN) {
      constexpr int dh_ = (u >> 2) * 2, s_ = u & 3;
      asm volatile("ds_read_b64_tr_b16 %0, %1 offset:%2" : "=v"(vl_[u % NPV][0]) : "v"(vfb), "i"(s_ * 1024 + dh_ * 4096));
      asm volatile("ds_read_b64_tr_b16 %0, %1 offset:%2" : "=v"(vh_[u % NPV][0]) : "v"(vfb), "i"(s_ * 1024 + dh_ * 4096 + 512));
      asm volatile("ds_read_b64_tr_b16 %0, %1 offset:%2" : "=v"(vl_[u % NPV][1]) : "v"(vfb), "i"(s_ * 1024 + (dh_ + 1) * 4096));
      asm volatile("ds_read_b64_tr_b16 %0, %1 offset:%2" : "=v"(vh_[u % NPV][1]) : "v"(vfb), "i"(s_ * 1024 + (dh_ + 1) * 4096 + 512));
    } else if constexpr (u < PVN + ND0) {
      constexpr int d0_ = u - PVN;
      asm volatile("ds_read_b128 %0, %1 offset:%2" : "=v"(kf_[d0_][0]) : "v"(kfb), "i"(d0_ * 2 * KSTR));
      asm volatile("ds_read_b128 %0, %1 offset:%2" : "=v"(kf_[d0_][1]) : "v"(kfb), "i"(d0_ * 2 * KSTR + 512));
    }
  };
  auto mop = [&](auto uc, auto pc, auto nopsc) {
    constexpr int u = decltype(uc)::value, PVN = decltype(pc)::value, NOPS = decltype(nopsc)::value;
    constexpr int n1 = (u + 1 >= NOPS) ? 0 : ((u + 1 < PVN) ? 4 : 2), n2 = (u + 2 >= NOPS) ? 0 : ((u + 2 < PVN) ? 4 : 2);
    if constexpr (u < PVN) {
      constexpr int dh_ = (u >> 2) * 2, s_ = u & 3;
      lds_wait4(std::integral_constant<int, n1 + n2>{}, vl_[u % NPV][0], vh_[u % NPV][0], vl_[u % NPV][1], vh_[u % NPV][1]);
#pragma unroll
      for (int dd = 0; dd < 2; ++dd) {
        const s16x8 vv = (s16x8){vl_[u % NPV][dd][0], vl_[u % NPV][dd][1], vl_[u % NPV][dd][2], vl_[u % NPV][dd][3], vh_[u % NPV][dd][0], vh_[u % NPV][dd][1], vh_[u % NPV][dd][2], vh_[u % NPV][dd][3]};
        o[dh_ + dd] = __builtin_amdgcn_mfma_f32_32x32x16_f16(__builtin_bit_cast(half8, vv), pb[s_], o[dh_ + dd], 0, 0, 0);
      }
    } else {
      constexpr int d0_ = u - PVN;
      lds_wait2(std::integral_constant<int, n1 + n2>{}, kf_[d0_][0], kf_[d0_][1]);
      if constexpr (d0_ == 0) { p0 = __builtin_amdgcn_mfma_f32_32x32x16_f16(kf_[0][0], qf[0], negm, 0, 0, 0); p1 = __builtin_amdgcn_mfma_f32_32x32x16_f16(kf_[0][1], qf[0], negm, 0, 0, 0); }
      else { p0 = __builtin_amdgcn_mfma_f32_32x32x16_f16(kf_[d0_][0], qf[d0_], p0, 0, 0, 0); p1 = __builtin_amdgcn_mfma_f32_32x32x16_f16(kf_[d0_][1], qf[d0_], p1, 0, 0, 0); }
    }
  };
  auto mhalf = [&](auto pc, auto nopsc, int vsl, int ksl) {
    constexpr int NOPS = decltype(nopsc)::value;
    vfb = ldsb + vsl * VSL + voff; kfb = ldsb + ksl * KSL + koff;
    rop(std::integral_constant<int, 0>{}, pc); rop(std::integral_constant<int, 1>{}, pc);
    __builtin_amdgcn_sched_barrier(0);
    static_for<NOPS>([&](auto uc) {
      constexpr int u = decltype(uc)::value;
      rop(std::integral_constant<int, u + 2>{}, pc);
      mop(uc, pc, nopsc);
      __builtin_amdgcn_sched_barrier(0);
    });
  };
  int s0 = 0, s1 = 1, s2 = 2;
  bool fullB = true;
  if (la) BAR();
  asm volatile(".p2align 8; .fill 8, 4, 0xBF800000;" ::: "memory");
  for (int t = 0; t < nt; ++t) {
    const bool fullA = (t + 2 < nt);
    if (!la) { if (t + 2 < nt) AT_KDMA(t + 2, s2); if (t + 1 < nt) AT_VDMA(t + 1, s1); }
    __builtin_amdgcn_s_setprio(1);
    if (t > 0) mhalf(std::integral_constant<int, NPV>{}, std::integral_constant<int, NPV + ND0>{}, s2, s0);
    else mhalf(std::integral_constant<int, 0>{}, std::integral_constant<int, ND0>{}, s2, s0);
    __builtin_amdgcn_s_setprio(0);
    if (la) AT_VMWAIT(fullB);
    BAR();
    if (la) { if (t + 3 < nt) AT_KDMA(t + 3, s0); if (t + 2 < nt) AT_VDMA(t + 2, s2); fullB = (t + 3 < nt); }
    int mb = max(__float_as_int(p0[0]), __float_as_int(p1[0]));
#pragma unroll
    for (int r = 1; r < 16; ++r) mb = max(mb, max(__float_as_int(p0[r]), __float_as_int(p1[r])));
    if (t == 0 || __any(mb > 0x41000000)) {
      float mx = fmaxf(p0[0], p1[0]);
#pragma unroll
      for (int r = 1; r < 16; ++r) mx = fmaxf(mx, fmaxf(p0[r], p1[r]));
      mx = swap_max(mx);
      const float dl = (t == 0) ? mx : fmaxf(mx, 0.f);
      const float alpha = __builtin_amdgcn_exp2f(-dl);
      mrun += dl;
#pragma unroll
      for (int r = 0; r < 16; ++r) { p0[r] -= dl; p1[r] -= dl; negm[r] = -mrun; }
      lrun *= alpha;
#pragma unroll
      for (int d = 0; d < NDB; ++d)
#pragma unroll
        for (int r = 0; r < 16; ++r) o[d][r] *= alpha;
    }
    float ps0 = 0.f, ps1 = 0.f;
#pragma unroll
    for (int r = 0; r < 16; ++r) { p0[r] = __builtin_amdgcn_exp2f(p0[r]); p1[r] = __builtin_amdgcn_exp2f(p1[r]); ps0 += p0[r]; ps1 += p1[r]; }
    lrun += ps0 + ps1;
#pragma unroll
    for (int j = 0; j < 8; ++j) { pb[0][j] = (half_t)p0[j]; pb[1][j] = (half_t)p0[8 + j]; pb[2][j] = (half_t)p1[j]; pb[3][j] = (half_t)p1[8 + j]; }
    if (!la) AT_VMWAIT(fullA);
    BAR();
    { const int tmp = s0; s0 = s1; s1 = s2; s2 = tmp; }
  }
  mhalf(std::integral_constant<int, NPV>{}, std::integral_constant<int, NPV>{}, s2, s0);
  if (!la) BAR();
#undef AT_NEXT
#undef AT_KDMA
#undef AT_VDMA
#undef AT_VMWAIT
  linv = 1.0f / swap_add(lrun);
  __syncthreads();
}

struct AttnGeom { int tok0, key0, nkeys, mrow; };
__device__ __forceinline__ AttnGeom attn_geom(bool latent, int b, int qb) {
  AttnGeom g;
  if (latent) { g.tok0 = NPT + b * LSEQ + qb * 256; g.key0 = 8192 + b * LKEYS; g.nkeys = LKEYS; }
  else { g.tok0 = b * 256; g.key0 = b * 256; g.nkeys = 256; }
  g.mrow = 0; return g;
}

template <int DV>
__device__ __forceinline__ void attn_prefetch_g(half8 (&gp)[DV / 16], const half_t* sg0) {
  constexpr int CH = DV / 8;
  const int lane = ltid() & 63;
#pragma unroll
  for (int i = 0; i < 32 * CH / 64; ++i) { const int idx = i * 64 + lane, row = idx / CH, ch = idx % CH; gp[i] = *(const half8*)(sg0 + (size_t)row * SGW + ch * 8); }
}
template <int DV>
__device__ __forceinline__ void attn_epilogue(const f32x16 (&o)[DV / 32], float scale, const float* sub, LAS char* st, half_t* sg0, int dry, const half8 (&gp)[DV / 16]) {
  constexpr int ROWB = DV * 2 + 16, CH = DV / 8;
  const int tid_ = ltid(), lane = tid_ & 63, r32 = lane & 31, hi = lane >> 5;
  f32x4 sbv[DV / 32][4];
  if (sub) {
#pragma unroll
    for (int d = 0; d < DV / 32; ++d)
#pragma unroll
      for (int q = 0; q < 4; ++q) sbv[d][q] = *(const f32x4*)(sub + d * 32 + q * 8 + hi * 4);
    __builtin_amdgcn_sched_barrier(0);
  }
#pragma unroll
  for (int d = 0; d < DV / 32; ++d)
#pragma unroll
    for (int q = 0; q < 4; ++q) {
      const int dv = d * 32 + q * 8 + hi * 4;
      f32x4 v; v[0] = o[d][q * 4] * scale; v[1] = o[d][q * 4 + 1] * scale; v[2] = o[d][q * 4 + 2] * scale; v[3] = o[d][q * 4 + 3] * scale;
      if (sub) v = v * sbv[d][q];
      *(LAS half4*)(st + r32 * ROWB + dv * 2) = to_half4(v);
    }
#pragma unroll
  for (int i = 0; i < 32 * CH / 64; ++i) {
    const int idx = i * 64 + lane, row = idx / CH, ch = idx % CH;
    const half8 v = *(LAS half8*)(st + row * ROWB + ch * 16);
    half_t* p = sg0 + (size_t)row * SGW + ch * 8;
    const half8 g = gp[i];
    half8 r = v * g;
    if (dry == 2) { const bool odd = ((float)r[0] == 12345.678f); r = odd ? r : g; }
    if (dry != 1) *(half8*)p = r;
  }
}

__device__ void mla_unit(const Params& P, bool latent, int b, int qb, int h, LAS char* lds, int dry) {
  const AttnGeom g = attn_geom(latent, b, qb);
  const half_t* QA = (const half_t*)(P.ws + WS_QA) + (size_t)g.tok0 * QAP + h * 96;
  const half_t* KVA = (const half_t*)(P.ws + WS_KVA) + (size_t)g.key0 * KVP + h * 128;
  const half_t* P1 = (const half_t*)(P.ws + WS_P1) + (size_t)g.key0 * P1W;
  f32x16 o[2]; float linv;
  const int wid = ltid() >> 6;
  half_t* sg0 = (half_t*)(P.ws + WS_SG) + (size_t)(g.tok0 + wid * 32) * SGW + 0 * 512 + h * 64;
  half8 gp[4]; attn_prefetch_g<64>(gp, sg0);
  attn_pass<8, 4, 64>(QA, QAP, KVA, KVP, P1 + C_KPE, P1W, KVA + 64, KVP, g.nkeys, lds, o, linv);
  attn_epilogue<64>(o, linv, nullptr, lds + wid * 4608, sg0, dry, gp);
}
__device__ void gqa_unit(const Params& P, bool latent, int b, int qb, int h, LAS char* lds, int dry) {
  const AttnGeom g = attn_geom(latent, b, qb);
  const half_t* P1 = (const half_t*)(P.ws + WS_P1);
  const half_t* Q = P1 + (size_t)tok_keyrow(g.tok0) * P1W + C_GQ + h * 64;
  const half_t* Kp = P1 + (size_t)g.key0 * P1W + C_GK + (h >> 2) * 64;
  const half_t* Vp = P1 + (size_t)g.key0 * P1W + C_GV + (h >> 2) * 64;
  f32x16 o[2]; float linv;
  const int wid = ltid() >> 6;
  half_t* sg0 = (half_t*)(P.ws + WS_SG) + (size_t)(g.tok0 + wid * 32) * SGW + 2 * 512 + h * 64;
  half8 gp[4]; attn_prefetch_g<64>(gp, sg0);
  attn_pass<8, 0, 64>(Q, P1W, Kp, P1W, Kp, P1W, Vp, P1W, g.nkeys, lds, o, linv);
  attn_epilogue<64>(o, linv, nullptr, lds + wid * 4608, sg0, dry, gp);
}
constexpr int O1S_BASE = 3 * (8448 + 16384), O1S_STRIDE = 8704;
__device__ void diff_unit(const Params& P, int l, bool latent, int b, int qb, int h, LAS char* lds, int dry, int pf) {
  const AttnGeom g = attn_geom(latent, b, qb);
  const half_t* P1 = (const half_t*)(P.ws + WS_P1);
  const half_t* Qb = P1 + (size_t)tok_keyrow(g.tok0) * P1W + C_DQ + h * 128;
  const half_t* Kb = P1 + (size_t)g.key0 * P1W + C_DK + h * 128;
  const half_t* Vp = P1 + (size_t)g.key0 * P1W + C_DV + h * 128;
  f32x16 o2[4]; float l2;
  const int tid0 = ltid(), wid = tid0 >> 6;
  LAS char* o1w = lds + O1S_BASE + wid * O1S_STRIDE;
  LAS char* o1s = o1w + (tid0 & 63) * 16;
  {
    f32x16 o1[4]; float l1;
    attn_pass<8, 0, 128>(Qb, P1W, Kb, P1W, Kb, P1W, Vp, P1W, g.nkeys, lds, o1, l1, pf);
#pragma unroll
    for (int d = 0; d < 4; ++d)
#pragma unroll
      for (int q = 0; q < 2; ++q) {
        half8 hv;
#pragma unroll
        for (int j = 0; j < 8; ++j) hv[j] = (half_t)(o1[d][q * 8 + j] * l1);
        *(LAS half8*)(o1s + (d * 2 + q) * 1024) = hv;
      }
  }
  half_t* sg0 = (half_t*)(P.ws + WS_SG) + (size_t)(g.tok0 + wid * 32) * SGW + 1 * 512 + h * 128;
  half8 gp[8]; attn_prefetch_g<128>(gp, sg0);
  attn_pass<8, 0, 128>(Qb + 64, P1W, Kb + 64, P1W, Kb + 64, P1W, Vp, P1W, g.nkeys, lds, o2, l2, pf);
  const float lam = ((const float*)(P.ws + WS_LAM))[l];
  const float lam_init = 0.8f - 0.6f * expf(-0.3f * (float)l);
  const float l2l = l2 * lam;
  float ss = 0.f;
#pragma unroll
  for (int d = 0; d < 4; ++d)
#pragma unroll
    for (int q = 0; q < 2; ++q) {
      const half8 hv = *(LAS half8*)(o1s + (d * 2 + q) * 1024);
#pragma unroll
      for (int j = 0; j < 8; ++j) { const float v = (float)hv[j] - l2l * o2[d][q * 8 + j]; o2[d][q * 8 + j] = v; ss += v * v; }
    }
  ss = swap_add(ss);
  const float rstd = rsqrtf(ss * (1.0f / 128.0f) + EPS) * (1.0f - lam_init);
  attn_epilogue<128>(o2, rstd, P.in[I_SUBLN] + l * 128, o1w, sg0, dry, gp);
}

constexpr int SSM_BU = 16 * 272, SSM_HS = 16 * 272, SSM_D = SSM_BU + SSM_HS, SSM_W = 2 * SSM_D;
template <bool STATE_ONLY>
__device__ void ssm_tile(const Params& P, int l, int rt, int oct, LAS char* lds, int sh) {
  const int c0 = STATE_ONLY ? sh * 8 : 0, c1 = STATE_ONLY ? c0 + 8 : 16;
  const int tid_ = ltid(), lane = tid_ & 63, wid = tid_ >> 6, fr = lane & 15, fq = lane >> 4;
  const int g = oct * 8 + wid;
  const bool latent = rt >= 32;
  const int tok0 = rt * 256, krow0 = tile_keyrow(rt);
  const int lb = (rt - 32) >> 3, lq = (rt - 32) & 7;
  LAS char* my = lds + wid * SSM_W;
  const half_t* P1 = (const half_t*)(P.ws + WS_P1);
  half_t* Y = (half_t*)(P.ws + WS_Y);
  float* HEND = (float*)(P.ws + WS_HEND);
  const f32x4 dco = *(const f32x4*)(P.in[I_SSMD] + l * 512 + g * 16 + fq * 4);
  half4 bmf[2][8]; half8 cmf[2][4]; float bsc[2], ar[2], ai[2], hr[2], hi_[2];
#pragma unroll
  for (int d = 0; d < 2; ++d) {
    const int idx = (l * 2 + d) * 32 + g;
    const half_t* bm = (const half_t*)(P.ws + WS_BM) + (size_t)idx * 2048;
    const half_t* cm = (const half_t*)(P.ws + WS_CM) + (size_t)idx * 2048;
#pragma unroll
    for (int tl = 0; tl < 8; ++tl) bmf[d][tl] = *(const half4*)(bm + (tl * 16 + fr) * 16 + fq * 4);
    if (!STATE_ONLY) {
#pragma unroll
      for (int ks = 0; ks < 4; ++ks) cmf[d][ks] = *(const half8*)(cm + fr * 128 + ks * 32 + fq * 8);
    }
    bsc[d] = ((const float*)(P.ws + WS_BSC))[idx];
    ar[d] = ((const float*)(P.ws + WS_ABAR))[((size_t)idx * 64 + lane) * 2]; ai[d] = ((const float*)(P.ws + WS_ABAR))[((size_t)idx * 64 + lane) * 2 + 1];
    hr[d] = 0.f; hi_[d] = 0.f;
    if (!STATE_ONLY && latent) {
      const float* st = P.in[I_STATE] + ((((size_t)lb * 2 + l) * 2 + d) * 32 + g) * 128 + lane * 2; hr[d] = st[0]; hi_[d] = st[1];
      const float a2r = ((const float*)(P.ws + WS_A256))[((size_t)idx * 64 + lane) * 2], a2i = ((const float*)(P.ws + WS_A256))[((size_t)idx * 64 + lane) * 2 + 1];
      const float a1r = ((const float*)(P.ws + WS_A128))[((size_t)idx * 64 + lane) * 2], a1i = ((const float*)(P.ws + WS_A128))[((size_t)idx * 64 + lane) * 2 + 1];
      const int nprev = d ? 7 - lq : lq;
      f32x2e h0[7], h1[7];
#pragma unroll
      for (int i = 0; i < 7; ++i) {
        const int jt = lb * 8 + (d ? 7 - i : i);
        h0[i] = (f32x2e){0.f, 0.f}; h1[i] = h0[i];
        if (i < nprev) { const float* he = HEND + ((((size_t)jt * 2) * 64 + d * 32 + g) * 64 + lane) * 2; h0[i] = *(const f32x2e*)he; h1[i] = *(const f32x2e*)(he + 64 * 64 * 2); }
      }
#pragma unroll
      for (int i = 0; i < 7; ++i) {
        if (i < nprev) {
          const float er = a1r * h0[i][0] - a1i * h0[i][1] + h1[i][0], ei = a1r * h0[i][1] + a1i * h0[i][0] + h1[i][1];
          const float nr = a2r * hr[d] - a2i * hi_[d] + er, ni = a2r * hi_[d] + a2i * hr[d] + ei; hr[d] = nr; hi_[d] = ni;
        }
      }
    }
  }
  const half_t* up = P1 + (size_t)(krow0 + fr) * P1W + C_U + g * 16 + fq * 4;
  half_t* ybase = Y + (size_t)(tok0 + fr) * YP + g * 16 + fq * 4;
#define SSM_CH(d, ci) ((d) ? 15 - (ci) : (ci))
#define SSM_LOADU(c) (*(const half4*)(up + (size_t)((c) * 16) * P1W))
#define SSM_BU_MFMA(d, u_, d_) do { _Pragma("unroll") for (int tl = 0; tl < 8; ++tl) { d_[tl] = (f32x4){0.f, 0.f, 0.f, 0.f}; d_[tl] = __builtin_amdgcn_mfma_f32_16x16x16f16(bmf[d][tl], u_, d_[tl], 0, 0, 0); } } while (0)
#define SSM_BU_STORE(d, d_) do { _Pragma("unroll") for (int tl = 0; tl < 8; ++tl) *(LAS half4*)(my + (d) * SSM_D + fr * 272 + (tl * 16 + fq * 4) * 2) = to_half4(d_[tl]); } while (0)
  half4 uf[2], ufn[2];
#pragma unroll
  for (int d = 0; d < 2; ++d) { uf[d] = SSM_LOADU(SSM_CH(d, c0)); f32x4 d0[8]; SSM_BU_MFMA(d, uf[d], d0); SSM_BU_STORE(d, d0); ufn[d] = SSM_LOADU(SSM_CH(d, c0 + 1)); }
  unsigned long long pvn[2] = {0ull, 0ull};
#define SSM_LOADY(d, ci) __hip_atomic_load((const unsigned long long*)(ybase + (size_t)(SSM_CH(d, ci) * 16) * YP), __ATOMIC_RELAXED, __HIP_MEMORY_SCOPE_AGENT)
  for (int ci = c0; ci < c1; ++ci) {
    half2v bb[2][16]; half4 ufnn[2]; unsigned long long pv[2];
    if (!STATE_ONLY && ci == 8) { WAIT_V(0); pvn[0] = SSM_LOADY(0, 8); pvn[1] = SSM_LOADY(1, 8); }
    pv[0] = pvn[0]; pv[1] = pvn[1];
    if (!STATE_ONLY && ci >= 8 && ci + 1 < 16) { pvn[0] = SSM_LOADY(0, ci + 1); pvn[1] = SSM_LOADY(1, ci + 1); }
#pragma unroll
    for (int d = 0; d < 2; ++d) {
#pragma unroll
      for (int tt = 0; tt < 16; ++tt) bb[d][tt] = *(LAS half2v*)(my + d * SSM_D + tt * 272 + lane * 4);
      ufnn[d] = (ci + 2 < c1) ? SSM_LOADU(SSM_CH(d, ci + 2)) : ufn[d];
    }
#pragma unroll
    for (int tt = 0; tt < 16; ++tt) {
#pragma unroll
      for (int d = 0; d < 2; ++d) {
        const int t = d ? 15 - tt : tt;
        const float br = (float)bb[d][t][0] * bsc[d], bi = (float)bb[d][t][1] * bsc[d];
        const float nhr = ar[d] * hr[d] - ai[d] * hi_[d] + br, nhi = ar[d] * hi_[d] + ai[d] * hr[d] + bi;
        hr[d] = nhr; hi_[d] = nhi;
        if (!STATE_ONLY) *(LAS half2v*)(my + d * SSM_D + SSM_BU + t * 272 + lane * 4) = (half2v){(half_t)nhr, (half_t)nhi};
      }
    }
#pragma unroll
    for (int d = 0; d < 2; ++d) {
      if (ci + 1 < c1) { f32x4 dn[8]; SSM_BU_MFMA(d, ufn[d], dn); SSM_BU_STORE(d, dn); }
      if (!STATE_ONLY) {
        f32x4 yv = (f32x4){0.f, 0.f, 0.f, 0.f};
#pragma unroll
        for (int ks = 0; ks < 4; ++ks) {
          const half8 hs = *(LAS half8*)(my + d * SSM_D + SSM_BU + fr * 272 + (ks * 32 + fq * 8) * 2);
          yv = __builtin_amdgcn_mfma_f32_16x16x32_f16(cmf[d][ks], hs, yv, 0, 0, 0);
        }
        half_t* yp = ybase + (size_t)(SSM_CH(d, ci) * 16) * YP;
        if (ci < 8) { *(half4*)yp = to_half4(yv); }
        else {
          const f32x4 prev = to_f32x4(__builtin_bit_cast(half4, pv[d]));
          const f32x4 uu = to_f32x4(uf[d]);
          f32x4 o;
#pragma unroll
          for (int j = 0; j < 4; ++j) o[j] = gelu_tanh(yv[j] + prev[j] + dco[j] * uu[j]);
          *(half4*)yp = to_half4(o);
        }
      }
      uf[d] = ufn[d]; ufn[d] = ufnn[d];
    }
  }
#undef SSM_LOADY
#undef SSM_CH
#undef SSM_LOADU
#undef SSM_BU_MFMA
#undef SSM_BU_STORE
#pragma unroll
  for (int d = 0; d < 2; ++d) {
    if (STATE_ONLY) { float* he = HEND + ((((size_t)(rt - 32) * 2 + sh) * 64 + d * 32 + g) * 64 + lane) * 2; he[0] = hr[d]; he[1] = hi_[d]; }
    else if (!latent) { float* so = P.out + O_ST + ((((size_t)(rt) * 2 + l) * 2 + d) * 32 + g) * 128 + lane * 2; so[0] = hr[d]; so[1] = hi_[d]; }
  }
}

__device__ void glu_unit(const Params& P, int l, int rt, int ct, LAS char* lds) {
  const half_t* Y = (const half_t*)(P.ws + WS_Y);
  const half_t* W = (const half_t*)(P.ws + WS_WGLU) + (size_t)l * 512 * WGLUP;
  half_t* SG = (half_t*)(P.ws + WS_SG);
  const float* gb = P.in[I_GLUB] + l * 512;
  {
    f32x4 acc[4][4]; zero_acc(acc);
    gemm_kloop(acc, Y + (size_t)rt * 256 * YP, YP, W + (size_t)ct * 128 * WGLUP, WGLUP, 512, lds);
    const half_t* ysrc = Y + (size_t)rt * 256 * YP + ct * 128;
    half_t* sp = SG + (size_t)rt * 256 * SGW + 1536 + ct * 128;
    f32x4 bbv[4]; half8 ya[8], sa[8];
    {
      EPI_COORDS
#pragma unroll
      for (int n = 0; n < 4; ++n) bbv[n] = *(const f32x4*)(gb + ct * 128 + wc * 64 + n * 16 + fq * 4);
#pragma unroll
      for (int i = 0; i < 8; ++i) {
        const int idx = i * 512 + tid, row = idx >> 4, c8 = (idx & 15) * 8;
        ya[i] = *(const half8*)(ysrc + (size_t)row * YP + c8); sa[i] = *(const half8*)(sp + (size_t)row * SGW + c8);
      }
      __builtin_amdgcn_sched_barrier(0);
#pragma unroll
      for (int n = 0; n < 4; ++n)
#pragma unroll
        for (int m = 0; m < 4; ++m)
#pragma unroll
          for (int j = 0; j < 4; ++j) acc[m][n][j] = sigmoidf_(acc[m][n][j] + bbv[n][j]);
    }
    half8 yg[8];
#pragma unroll
    for (int i = 0; i < 8; ++i) yg[i] = ya[i] * sa[i];
    stage_tile(acc, lds);
    {
      const int tid = ltid();
      __syncthreads();
#pragma unroll
      for (int i = 0; i < 8; ++i) {
        const int idx = i * 512 + tid, row = idx >> 4, ch = idx & 15;
        const half8 v = *(LAS half8*)(lds + row * STG_ROWB + ch * 16);
        *(half8*)(sp + (size_t)row * SGW + ch * 8) = v * yg[i];
      }
      __syncthreads();
    }
  }
}

__device__ void phase_mix(const Params& P, int l, int inv, int modef, LAS char* lds) {
  const int mode = modef & 15;
  constexpr int U1 = 64, U2 = U1 + 128, U3 = U2 + 128, U4 = U3 + 192, U5 = U4 + 128, U6 = U5 + 256, U7 = U6 + 256;
  const int U7T = U7 + ((l == 0) ? T_LAYER / 8 : 0), U8 = U7T + 192;
  unsigned* cntY = (unsigned*)(P.ws + WS_CTRL) + 10240 + (inv * 2 + l) * 64;
  unsigned* ctr = (unsigned*)(P.ws + WS_CTRL) + 8192 + (inv * 2 + l) * 64;
  LAS int* slot = (LAS int*)(lds + LDS_BYTES - 16);
  bool first = true;
  for (;;) {
    __syncthreads();
    if (threadIdx.x == 0) *slot = first ? (int)blockIdx.x : (int)(atomicAdd(ctr, 1u) + gridDim.x);
    __syncthreads();
    first = false;
    const int u = *slot;
    if (u >= U8) break;
    int type, latent = 0, b = 0, qb = 0, h;
    if (u < U1) { const int v = u; type = 1; latent = 1; b = v >> 5; qb = (v >> 2) & 7; h = v & 3; }
    else if (u < U2) { const int v = u - U1; type = 0; latent = 1; b = v >> 6; qb = (v >> 3) & 7; h = v & 7; }
    else if (u < U3) { const int v = u - U2; type = 2; latent = 1; b = v >> 6; qb = (v >> 3) & 7; h = v & 7; }
    else if (u < U4) { const int v = u - U3; type = 3; b = 47 - (v >> 2); h = v & 3; }
    else if (u < U5) { const int v = u - U4; type = 1; b = v >> 2; h = v & 3; }
    else if (u < U6) { const int v = u - U5; type = 0; b = v >> 3; h = v & 7; }
    else if (u < U7) { const int v = u - U6; type = 2; b = v >> 3; h = v & 7; }
    else if (u < U7T) { type = 5; b = u - U7; h = 0; }
    else { const int v = u - U7T; type = 4; b = 47 - (v >> 2); h = v & 3; }
    bool skip = false;
    if (mode != 0 && type >= 4) skip = true;
    if (mode == 1 && type != 3) skip = true;
    if (mode == 2 && (type == 3 || !latent)) skip = true;
    if (mode == 3 && type == 3) skip = true;
    if (mode == 6 && type == 3) skip = true;
    if (mode == 7 && !(type == 1 && latent)) skip = true;
    if (mode == 8 && !(type == 0 && latent)) skip = true;
    if (mode == 9 && !(type == 2 && latent)) skip = true;
    if (mode == 10 && (type == 3 || latent)) skip = true;
    const int dry = (mode == 0) ? 0 : ((mode >= 5) ? 2 : 1);
    if (!skip) {
      if (type == 5) transpose_unit(P, 1, b * 8 + (int)(threadIdx.x >> 6), lds + (threadIdx.x >> 6) * (64 * 65 * 4));
      else if (type == 0) mla_unit(P, latent != 0, b, qb, h, lds, dry);
      else if (type == 1) diff_unit(P, l, latent != 0, b, qb, h, lds, dry, modef >> 4);
      else if (type == 2) gqa_unit(P, latent != 0, b, qb, h, lds, dry);
      else if (type == 3) {
        ssm_tile<false>(P, l, b, h, lds);
        asm volatile("s_waitcnt vmcnt(0)" ::: "memory");
        __syncthreads();
        if (threadIdx.x == 0) {
          __builtin_amdgcn_fence(__ATOMIC_RELEASE, "agent");
          asm volatile("s_waitcnt vmcnt(0)" ::: "memory");
          if (mode == 0) __hip_atomic_fetch_add(&cntY[b], 1u, __ATOMIC_RELAXED, __HIP_MEMORY_SCOPE_AGENT);
        }
      } else {
        if (threadIdx.x == 0) {
          unsigned sp = 0;
          while (__hip_atomic_load(&cntY[b], __ATOMIC_RELAXED, __HIP_MEMORY_SCOPE_AGENT) < 4u) { __builtin_amdgcn_s_sleep(2); if (++sp > (1u << 24)) break; }
          __builtin_amdgcn_fence(__ATOMIC_ACQUIRE, "agent");
          asm volatile("s_waitcnt vmcnt(0)" ::: "memory");
        }
        __syncthreads();
        glu_unit(P, l, b, h, lds);
      }
    }
  }
}

__device__ void phase_branch(const Params& P, int l, LAS char* lds, int kk = 512, int abl = 0) {
  const half_t* WBR = (const half_t*)(P.ws + WS_WBR) + (size_t)l * 4 * 1024 * WBRP;
  const half_t* ABR = (const half_t*)(P.ws + WS_SG);
  half_t* BRO = (half_t*)(P.ws + WS_BRO);
  (void)abl;
  gemm256_stream<16, true>(
      [&](int i, const half_t*& A, const half_t*& Bt) {
        const int u = (int)blockIdx.x + i * (int)gridDim.x;
        if (u >= 48 * 16) return false;
        const int ct = u / 48, rt = u % 48;
        A = ABR + (size_t)rt * 256 * SGW + (ct >> 2) * 512; Bt = WBR + (size_t)ct * 256 * WBRP; return true; },
      SGW, WBRP, kk, lds,
      [&](int i, const f32x4 (&acc)[2][2][4][2]) {
        const int u = (int)blockIdx.x + i * (int)gridDim.x, ct = u / 48, rt = u % 48;
        half_t* dst = BRO + (size_t)rt * 256 * BROP + ct * 256;
        epi_perm256(acc, [&](int row, int c8, half8 v) { *(half8*)(dst + (size_t)row * BROP + c8) = v; }); });
}

__device__ void phase_merge(const Params& P, int l, LAS char* lds) {
  const half_t* H = (const half_t*)(P.ws + WS_H);
  const half_t* WM = (const half_t*)(P.ws + WS_WIN) + (size_t)l * NW1 * WINP + (size_t)5376 * WINP;
  const half_t* BRO = (const half_t*)(P.ws + WS_BRO);
  half_t* MG = (half_t*)(P.ws + WS_MG);
  for (int u = blockIdx.x; u < 48 * 16; u += gridDim.x) {
    const int dt = u / 48, rt = u % 48;
    f32x4 acc[2][2][4][2]; zero_acc256(acc);
    gemm256_kloop(acc, H + (size_t)rt * 256 * HP, HP, WM + (size_t)dt * 64 * WINP, WINP, 1024, lds, 960, 2048);
    const int tid = ltid();
    f32x4 sum[4][2];
    half8 bro[2][4][2];
#define M2_LOAD(bj) do { _Pragma("unroll") for (int i = 0; i < 4; ++i) { const int idx = i * 512 + tid, row = idx >> 3, c8 = (idx & 7) * 8; \
      const half_t* bp = BRO + (size_t)(rt * 256 + row) * BROP + (2 * (bj)) * 1024 + dt * 64 + c8; bro[bj][i][0] = *(const half8*)bp; bro[bj][i][1] = *(const half8*)(bp + 1024); } } while (0)
    M2_LOAD(0);
#pragma unroll
    for (int a = 0; a < 2; ++a)
#pragma unroll
      for (int b2 = 0; b2 < 2; ++b2)
#pragma unroll
        for (int m = 0; m < 4; ++m)
#pragma unroll
          for (int n = 0; n < 2; ++n)
#pragma unroll
            for (int j = 0; j < 4; ++j) acc[a][b2][m][n][j] = __builtin_amdgcn_rcpf(1.0f + __builtin_amdgcn_exp2f(acc[a][b2][m][n][j]));
#pragma unroll
    for (int bj = 0; bj < 2; ++bj) {
      stage_half256(acc, bj, lds);
      if (bj == 0) M2_LOAD(1);
      __syncthreads();
#pragma unroll
      for (int i = 0; i < 4; ++i) {
        const int idx = i * 512 + tid, row = idx >> 3, c8 = (idx & 7) * 8;
        const half8 g0 = *(LAS half8*)(lds + row * STG_ROWB + c8 * 2), g1 = *(LAS half8*)(lds + row * STG_ROWB + (64 + c8) * 2);
#pragma unroll
        for (int j = 0; j < 8; ++j) {
          const float t = (float)g0[j] * (float)bro[bj][i][0][j] + (float)g1[j] * (float)bro[bj][i][1][j];
          if (bj == 0) sum[i][j >> 2][j & 3] = t; else sum[i][j >> 2][j & 3] += t;
        }
      }
      __syncthreads();
    }
#undef M2_LOAD
#pragma unroll
    for (int i = 0; i < 4; ++i) {
      const int idx = i * 512 + tid, row = idx >> 3, c8 = (idx & 7) * 8;
      half8 o;
#pragma unroll
      for (int j = 0; j < 8; ++j) o[j] = (half_t)sum[i][j >> 2][j & 3];
      *(half8*)(MG + (size_t)(rt * 256 + row) * MGP + dt * 64 + c8) = o;
    }
  }
}

__device__ void phase_out(const Params& P, int l, LAS char* lds) {
  const half_t* MG = (const half_t*)(P.ws + WS_MG);
  const half_t* W = (const half_t*)(P.ws + WS_WOUT) + (size_t)l * 1024 * WOUTP;
  for (int u = blockIdx.x; u < 48 * 4; u += gridDim.x) {
    const int ct = u / 48, rt = u % 48;
    f32x4 acc[2][2][4][2]; zero_acc256(acc);
    gemm256_kloop(acc, MG + (size_t)rt * 256 * MGP, MGP, W + (size_t)ct * 256 * WOUTP, WOUTP, 1024, lds, 0, 128, 0, true);
    const int tid = ltid(), lane = tid & 63, wid = tid >> 6, wr = wid >> 2, wc = wid & 3, fr = lane & 15, fq = lane >> 4;
#pragma unroll
    for (int ai = 0; ai < 2; ++ai)
#pragma unroll
      for (int m = 0; m < 4; ++m) {
        const int r = rt * 256 + ai * 128 + wr * 64 + m * 16 + fr;
        const float* ga = (const float*)(P.ws + WS_MOD) + ((size_t)l * 3 + tok_modrow(r)) * 3072 + 2048;
        if (l == 0) {
          const float* xr = xin_row(P, r);
          half_t* xo = x1_row(P, r);
#pragma unroll
          for (int bj = 0; bj < 2; ++bj) {
            const int c = ct * 256 + bj * 128 + wc * 32 + fq * 8;
            const f32x4 x0 = *(const f32x4*)(xr + c), x1 = *(const f32x4*)(xr + c + 4), g0 = *(const f32x4*)(ga + c), g1 = *(const f32x4*)(ga + c + 4);
            const f32x4 o0 = x0 + g0 * acc[ai][bj][m][0], o1 = x1 + g1 * acc[ai][bj][m][1];
            half8 o; o[0] = (half_t)o0[0]; o[1] = (half_t)o0[1]; o[2] = (half_t)o0[2]; o[3] = (half_t)o0[3]; o[4] = (half_t)o1[0]; o[5] = (half_t)o1[1]; o[6] = (half_t)o1[2]; o[7] = (half_t)o1[3];
            *(half8*)(xo + c) = o;
          }
        } else {
          const half_t* xr = x1_row(P, r);
          half_t* xo = x2_row(P, r);
#pragma unroll
          for (int bj = 0; bj < 2; ++bj) {
            const int c = ct * 256 + bj * 128 + wc * 32 + fq * 8;
            const half8 xh = *(const half8*)(xr + c);
            const f32x4 g0 = *(const f32x4*)(ga + c), g1 = *(const f32x4*)(ga + c + 4);
            half8 o;
#pragma unroll
            for (int j = 0; j < 4; ++j) { o[j] = (half_t)((float)xh[j] + g0[j] * acc[ai][bj][m][0][j]); o[4 + j] = (half_t)((float)xh[4 + j] + g1[j] * acc[ai][bj][m][1][j]); }
            *(half8*)(xo + c) = o;
          }
        }
      }
  }
}

#define XB_TMO      128
#define XB_XCNT(j)  (256  + 64 * (j))
#define XB_XSUB(j)  (1280 + 64 * (j))
#define XB_XGEN(j)  (2304 + 64 * (j))
#define XB_TOP      3328
#define XB_TOPGEN   3392
#define XB_SPIN_CAP (1u << 22)
__device__ __forceinline__ unsigned xb_ld(unsigned* p)              { return __hip_atomic_load(p, __ATOMIC_RELAXED, __HIP_MEMORY_SCOPE_AGENT); }
__device__ __forceinline__ unsigned xb_add(unsigned* p, unsigned v) { return __hip_atomic_fetch_add(p, v, __ATOMIC_RELAXED, __HIP_MEMORY_SCOPE_AGENT); }
__device__ __forceinline__ unsigned xb_xcc_id() { return (unsigned)__builtin_amdgcn_s_getreg((3 << 11) | 20) & 0xFu; }
#define XB_SPIN(cond, bar) do { unsigned _sp = 0; while (cond) { __builtin_amdgcn_s_sleep(1); \
    if ((++_sp & 255u) == 0u) { if (xb_ld(&(bar)[XB_TMO])) break; if (_sp > XB_SPIN_CAP) { atomicAdd(&(bar)[XB_TMO], 1u); break; } } } } while (0)
struct XcdBarrier { unsigned* bar; unsigned x; volatile LAS unsigned* st; };
__device__ __forceinline__ XcdBarrier xcd_barrier_post(unsigned* bar, volatile LAS unsigned* st) {
  XcdBarrier b; b.bar = bar; b.x = xb_xcc_id(); b.st = st;
  if (threadIdx.x == 0) (void)xb_add(&bar[XB_XCNT(b.x)], 1u);
  return b;
}
__device__ __forceinline__ void xcd_barrier_complete(unsigned* bar, unsigned x, unsigned& nloc, unsigned& nx) {
  const unsigned G = gridDim.x * gridDim.y * gridDim.z;
  unsigned sum, cnt, mine, sp = 0u;
  for (;;) {
    sum = 0u; cnt = 0u; mine = 0u;
#pragma unroll
    for (unsigned j = 0; j < 16; ++j) { const unsigned c = xb_ld(&bar[XB_XCNT(j)]); sum += c; cnt += (c > 0u) ? 1u : 0u; mine = (j == x) ? c : mine; }
    if (sum == G) break;
    __builtin_amdgcn_s_sleep(1);
    if ((++sp & 255u) == 0u) { if (xb_ld(&bar[XB_TMO])) break; if (sp > XB_SPIN_CAP) { atomicAdd(&bar[XB_TMO], 1u); break; } }
  }
  nloc = mine > 0u ? mine : 1u; nx = cnt > 0u ? cnt : 1u;
}
__device__ __forceinline__ void xcd_barrier(const XcdBarrier& b) {
  asm volatile("s_waitcnt vmcnt(0)" ::: "memory");
  __syncthreads();
  if (threadIdx.x == 0) {
    unsigned* bar = b.bar;
    __builtin_amdgcn_s_waitcnt(0);
    unsigned nloc = b.st[0], nx = b.st[1];
    if (nloc == 0u) { xcd_barrier_complete(bar, b.x, nloc, nx); b.st[0] = nloc; b.st[1] = nx; }
    const unsigned old = xb_add(&bar[XB_XSUB(b.x)], 1u);
    const unsigned gen = old / nloc;
    if (old + 1u == (gen + 1u) * nloc) {
      __builtin_amdgcn_fence(__ATOMIC_RELEASE, "agent");
      asm volatile("s_waitcnt vmcnt(0)" ::: "memory");
      const unsigned og = xb_add(&bar[XB_TOP], 1u);
      const unsigned tg = og / nx;
      if (og + 1u == (tg + 1u) * nx) xb_add(&bar[XB_TOPGEN], 1u);
      else XB_SPIN(xb_ld(&bar[XB_TOPGEN]) == tg, bar);
      __builtin_amdgcn_fence(__ATOMIC_ACQUIRE, "agent");
      asm volatile("s_waitcnt vmcnt(0)" ::: "memory");
    } else {
      XB_SPIN(xb_ld(&bar[XB_TOPGEN]) == gen, bar);
      __builtin_amdgcn_fence(__ATOMIC_ACQUIRE, "agent");
      asm volatile("s_waitcnt vmcnt(0)" ::: "memory");
    }
  }
  __syncthreads();
}

#ifndef PROBE
#define PROBE 0
#endif
#define PH(id, l) ((id) | ((l) << 4))
#define PHA(id, l, arg) ((id) | ((l) << 4) | ((arg) << 5))
#define LAYER(l) PH(1, l), PH(2, l), PH(4, l), PH(5, l), PH(7, l), PH(8, l), PH(9, l)
__device__ const int PROG[] = {
#if PROBE == 0 || (PROBE >= 10 && PROBE <= 12)
  LAYER(0), LAYER(1), PH(10, 0)
#elif PROBE == 1
  PH(1, 0), LAYER(0), PH(1, 1), LAYER(1), PH(10, 0)
#elif PROBE == 2
  PH(1, 0), PH(2, 0), PH(2, 0), PH(4, 0), PH(5, 0), PH(7, 0), PH(8, 0), PH(9, 0), PH(1, 1), PH(2, 1), PH(2, 1), PH(4, 1), PH(5, 1), PH(7, 1), PH(8, 1), PH(9, 1), PH(10, 0)
#elif PROBE == 4
  PH(1, 0), PH(2, 0), PH(4, 0), PH(4, 0), PH(5, 0), PH(7, 0), PH(8, 0), PH(9, 0), PH(1, 1), PH(2, 1), PH(4, 1), PH(4, 1), PH(5, 1), PH(7, 1), PH(8, 1), PH(9, 1), PH(10, 0)
#elif PROBE == 5
  PH(1, 0), PH(2, 0), PH(4, 0), PH(5, 0), PH(2, 0), PH(4, 0), PHA(5, 0, 0) | (1 << 9), PH(7, 0), PH(8, 0), PH(9, 0), PH(1, 1), PH(2, 1), PH(4, 1), PH(5, 1), PH(2, 1), PH(4, 1), PHA(5, 1, 0) | (1 << 9), PH(7, 1), PH(8, 1), PH(9, 1), PH(10, 0)
#elif PROBE >= 40 && PROBE < 56
  PH(1, 0), PH(2, 0), PH(4, 0), PH(5, 0), PHA(7, 0, PROBE - 40), PH(7, 0), PH(8, 0), PH(9, 0), PH(1, 1), PH(2, 1), PH(4, 1), PH(5, 1), PHA(7, 1, PROBE - 40), PH(7, 1), PH(8, 1), PH(9, 1), PH(10, 0)
#elif PROBE == 7
  PH(1, 0), PH(2, 0), PH(4, 0), PH(5, 0), PH(7, 0), PH(7, 0), PH(8, 0), PH(9, 0), PH(1, 1), PH(2, 1), PH(4, 1), PH(5, 1), PH(7, 1), PH(7, 1), PH(8, 1), PH(9, 1), PH(10, 0)
#elif PROBE == 8
  PH(1, 0), PH(2, 0), PH(4, 0), PH(5, 0), PH(7, 0), PH(8, 0), PH(8, 0), PH(9, 0), PH(1, 1), PH(2, 1), PH(4, 1), PH(5, 1), PH(7, 1), PH(8, 1), PH(8, 1), PH(9, 1), PH(10, 0)
#elif PROBE == 9
  PH(1, 0), PH(2, 0), PH(4, 0), PH(5, 0), PH(7, 0), PH(8, 0), PH(9, 0), PH(9, 0), PH(9, 0), LAYER(1), PH(10, 0)
#else
  PH(1, 0), PH(2, 0), PH(4, 0), PH(5, 0), PHA(5, 0, PROBE - 16), PH(7, 0), PH(8, 0), PH(9, 0), PH(1, 1), PH(2, 1), PH(4, 1), PH(5, 1), PHA(5, 1, PROBE - 16), PH(7, 1), PH(8, 1), PH(9, 1), PH(10, 0)
#endif
};
constexpr int N_PROG = sizeof(PROG) / sizeof(int);
constexpr int N_PHASES = 64;
__global__ void __launch_bounds__(NTHR, 2) fwd_kernel(Params P, int p_lo, int p_hi) {
  extern __shared__ __attribute__((aligned(16))) char smem_raw[];
  LAS char* lds = (LAS char*)smem_raw;
#if ONE_LAUNCH
  volatile LAS unsigned* xst = (volatile LAS unsigned*)(lds + LDS_BYTES - 32);
  if (threadIdx.x == 0) { xst[0] = 0u; xst[1] = 0u; }
  __syncthreads();
  (void)xcd_barrier_post((unsigned*)(P.ws + WS_CTRL), xst);
#endif
#define SEAM() do { XcdBarrier xb_; xb_.bar = (unsigned*)(P.ws + WS_CTRL); xb_.x = xb_xcc_id(); xb_.st = (volatile LAS unsigned*)(lds + LDS_BYTES - 32); xcd_barrier(xb_); } while (0)
  { int npro = (PROBE >= 10 && PROBE <= 12) ? 2 : 1; asm volatile("" : "+s"(npro)); for (int r = 0; r < npro; ++r) { phase_prologue(P, lds, (r == 0 || PROBE == 10) ? 3 : PROBE - 10); if (r + 1 < npro) SEAM(); } }
  int i0 = 0;
#if PROBE == 0
  if (P.ws != nullptr) {
    if (threadIdx.x == 0) {
      unsigned sp = 0;
      while (__hip_atomic_load((unsigned*)(P.ws + WS_CTRL) + 12288, __ATOMIC_RELAXED, __HIP_MEMORY_SCOPE_AGENT) < 96u) { __builtin_amdgcn_s_sleep(2); if (++sp > (1u << 24)) break; }
      __builtin_amdgcn_fence(__ATOMIC_ACQUIRE, "agent");
      asm volatile("s_waitcnt vmcnt(0)" ::: "memory");
    }
    __syncthreads();
    phase_norm(P, 0);
    i0 = 1;
  }
#endif
  if (P.ws == nullptr) cg::this_grid().sync(); else SEAM();
  for (int i = i0; i < N_PROG; ++i) {
    const int code = PROG[i], id = code & 15, l = (code >> 4) & 1, arg = (code >> 5) & 15, second = code >> 9;
    switch (id) {
      case 1: phase_norm(P, l); break;
      case 2: phase_gemm1(P, l, lds); break;
      case 4: phase_gemm2(P, l, lds); break;
      case 5: phase_mix(P, l, (arg || second) ? 2 : 0, arg, lds); break;
      case 7: phase_branch(P, l, lds, 512, arg); break;
      case 8: phase_merge(P, l, lds); break;
      case 9: phase_out(P, l, lds); break;
      default: phase_final(P); break;
    }
    if (i + 1 < N_PROG) SEAM();
  }
}

extern "C" void kernel_launch(void* const* d_in, const int* in_sizes, int n_in, void* d_out, int out_size, void* d_ws, size_t ws_size, hipStream_t stream) {
  static int grid = 0;
  if (grid == 0) {
    if (n_in != 39 || ws_size < WS_END) { fprintf(stderr, "kernel_launch: need 39 inputs and %zu bytes of workspace (got %d, %zu)\n", (size_t)WS_END, n_in, ws_size); grid = -1; return; }
    int dev = 0, cus = 0;
    hipGetDevice(&dev);
    hipDeviceGetAttribute(&cus, hipDeviceAttributeMultiprocessorCount, dev);
    hipFuncSetAttribute((const void*)fwd_kernel, hipFuncAttributeMaxDynamicSharedMemorySize, LDS_BYTES);
    int per_cu = 0;
    hipOccupancyMaxActiveBlocksPerMultiprocessor(&per_cu, (const void*)fwd_kernel, NTHR, LDS_BYTES);
    (void)hipGetLastError();
    if (per_cu < 1) { fprintf(stderr, "kernel_launch: occupancy query says %d blocks per CU\n", per_cu); grid = -1; return; }
    grid = cus;
  }
  if (grid < 0) return;
  Params p{};
  for (int i = 0; i < 39; ++i) p.in[i] = (const float*)d_in[i];
  p.out = (float*)d_out; p.ws = (char*)d_ws;
  hipMemsetAsync(d_ws, 0, 65536, stream);
#if ONE_LAUNCH
  int lo = 0, hi = N_PHASES;
  void* args[] = {&p, &lo, &hi};
  hipError_t e = hipLaunchCooperativeKernel((const void*)fwd_kernel, dim3(grid), dim3(NTHR), args, LDS_BYTES, stream);
  if (e != hipSuccess) fprintf(stderr, "cooperative launch failed: %s\n", hipGetErrorString(e));
#else
  for (int ph = 0; ph < N_PHASES; ++ph) fwd_kernel<<<dim3(grid), dim3(NTHR), LDS_BYTES, stream>>>(p, ph, ph + 1);
#endif
}
```
